# Optimizing an MI355X kernel written in HIP

```python
import math
import jax, jax.numpy as jnp
from jax import lax
import numpy as np

D_MODEL = 1024
BATCH = 8
SEQ = 4096
DEPTH = 4

HEAD_DIM = 64
BLOCK = 128
RMS_EPS = 1e-6
SUBLN_EPS = 1e-5
A_HEADS = 4
A_QK = A_HEADS * 2 * HEAD_DIM
A_WIDTH = A_HEADS * 2 * HEAD_DIM
B_HEADS = 8
B_KV_HEADS = 2
B_GROUP = B_HEADS // B_KV_HEADS
B_WIDTH = B_HEADS * HEAD_DIM
B_KV = B_KV_HEADS * HEAD_DIM
WINDOW = 128
C_HEADS = 8
C_WIDTH = C_HEADS * HEAD_DIM
N_BRANCH = 3
SPLITS = (A_QK, A_QK, A_WIDTH, A_WIDTH,
          B_WIDTH, B_KV, B_KV, B_WIDTH,
          C_WIDTH, C_WIDTH, C_WIDTH, C_HEADS, C_WIDTH,
          N_BRANCH * D_MODEL)
D_IN = sum(SPLITS)

kernel_name = "hybrid_diff_swa_fox_gated_block"


def rms_norm(x, gain, eps):
    xf = x.astype(jnp.float32)
    y = xf * lax.rsqrt(jnp.mean(xf * xf, axis=-1, keepdims=True) + eps)
    return (y * gain.astype(jnp.float32)).astype(x.dtype)


def alibi_slopes(n_heads):
    return 2.0 ** (-8.0 * jnp.arange(1, n_heads + 1, dtype=jnp.float32) / n_heads)


def diff_attention(q, k, v, lam, slopes):
    B, S, H, _, d = q.shape
    nb = S // BLOCK
    scale = d ** -0.5
    qb = jnp.moveaxis(q.reshape(B, nb, BLOCK, H, 2, d), 1, 0)
    k_pos = jnp.arange(S)

    def one_block(args):
        qblk, start = args
        s = jnp.einsum('bqhmd,bkhmd->bhmqk', qblk, k).astype(jnp.float32) * scale
        dist = (start + jnp.arange(BLOCK))[:, None] - k_pos[None, :]
        bias = jnp.where(dist >= 0, -slopes[:, None, None] * dist.astype(jnp.float32), -jnp.inf)
        p = jax.nn.softmax(s + bias[None, :, None], axis=-1)
        w = p[:, :, 0] - lam * p[:, :, 1]
        return jnp.einsum('bhqk,bkhe->bqhe', w.astype(v.dtype), v)

    out = lax.map(one_block, (qb, jnp.arange(nb) * BLOCK))
    return jnp.moveaxis(out, 0, 1).reshape(B, S, H, v.shape[-1])


def sliding_window_attention(q, k, v, sinks, slopes):
    B, S, HQ, d = q.shape
    KV = k.shape[2]
    G = HQ // KV
    nb = S // BLOCK
    scale = d ** -0.5
    qb = q.reshape(B, nb, BLOCK, KV, G, d)

    def banded(t):
        tb = t.reshape(B, nb, BLOCK, KV, d)
        prev = jnp.concatenate([jnp.zeros_like(tb[:, :1]), tb[:, :-1]], axis=1)
        return jnp.concatenate([prev, tb], axis=2)

    kb, vb = banded(k), banded(v)
    s = jnp.einsum('bnqhgd,bnkhd->bnhgqk', qb, kb).astype(jnp.float32) * scale
    i = jnp.arange(BLOCK)[:, None]
    j = jnp.arange(2 * BLOCK)[None, :]
    dist = i - j + BLOCK
    key_pos = jnp.arange(nb)[:, None, None] * BLOCK + j - BLOCK
    valid = (dist >= 0) & (dist < WINDOW) & (key_pos >= 0)
    bias = -slopes.reshape(KV, G)[:, :, None, None] * dist.astype(jnp.float32)
    s = jnp.where(valid[None, :, None, None], s + bias[None, None], -jnp.inf)
    sink = sinks.astype(jnp.float32).reshape(KV, G)[None, None, :, :, None, None]
    m = jnp.maximum(jnp.max(s, axis=-1, keepdims=True), sink)
    e = jnp.exp(s - m)
    p = e / (jnp.sum(e, axis=-1, keepdims=True) + jnp.exp(sink - m))
    out = jnp.einsum('bnhgqk,bnkhd->bnqhgd', p.astype(v.dtype), vb)
    return out.reshape(B, S, HQ * d)


def forgetting_attention(q, k, v, logf):
    B, S, H, d = q.shape
    nb = S // BLOCK
    scale = d ** -0.5
    c = jnp.cumsum(logf, axis=1)
    c_k = jnp.transpose(c, (0, 2, 1))
    qb = jnp.moveaxis(q.reshape(B, nb, BLOCK, H, d), 1, 0)
    cb = jnp.moveaxis(c.reshape(B, nb, BLOCK, H), 1, 0)
    k_pos = jnp.arange(S)

    def one_block(args):
        qblk, cblk, start = args
        s = jnp.einsum('bqhd,bkhd->bhqk', qblk, k).astype(jnp.float32) * scale
        decay = jnp.transpose(cblk, (0, 2, 1))[:, :, :, None] - c_k[:, :, None, :]
        dist = (start + jnp.arange(BLOCK))[:, None] - k_pos[None, :]
        s = jnp.where((dist >= 0)[None, None], s + decay, -jnp.inf)
        p = jax.nn.softmax(s, axis=-1)
        return jnp.einsum('bhqk,bkhd->bqhd', p.astype(v.dtype), v)

    out = lax.map(one_block, (qb, cb, jnp.arange(nb) * BLOCK))
    return jnp.moveaxis(out, 0, 1).reshape(B, S, H * d)


def setup_inputs(seed: int = 0) -> dict:
    key = jax.random.key(seed)
    ks = jax.random.split(key, 16)
    f32 = jnp.float32
    nrm = lambda k, shape: jax.random.normal(k, shape, dtype=f32)
    return {
        "x": nrm(ks[0], (BATCH, SEQ, D_MODEL)),
        "norm_gain": 1.0 + 0.05 * nrm(ks[1], (DEPTH, D_MODEL)),
        "w_in": nrm(ks[2], (DEPTH, D_MODEL, D_IN)) * D_MODEL ** -0.5,
        "b_forget": 0.1 * nrm(ks[3], (DEPTH, C_HEADS)),
        "lambda_q1": 0.1 * nrm(ks[4], (DEPTH, HEAD_DIM)),
        "lambda_k1": 0.1 * nrm(ks[5], (DEPTH, HEAD_DIM)),
        "lambda_q2": 0.1 * nrm(ks[6], (DEPTH, HEAD_DIM)),
        "lambda_k2": 0.1 * nrm(ks[7], (DEPTH, HEAD_DIM)),
        "subln_gain": 1.0 + 0.05 * nrm(ks[8], (DEPTH, 2 * HEAD_DIM)),
        "sinks": 0.5 * nrm(ks[9], (DEPTH, B_HEADS)),
        "w_up_a": nrm(ks[10], (DEPTH, A_WIDTH, D_MODEL)) * A_WIDTH ** -0.5,
        "w_up_b": nrm(ks[11], (DEPTH, B_WIDTH, D_MODEL)) * B_WIDTH ** -0.5,
        "w_up_c": nrm(ks[12], (DEPTH, C_WIDTH, D_MODEL)) * C_WIDTH ** -0.5,
        "w_o": nrm(ks[13], (DEPTH, D_MODEL, D_MODEL)) * D_MODEL ** -0.5,
        "final_gain": 1.0 + 0.05 * nrm(ks[14], (D_MODEL,)),
    }


def reference(x, norm_gain, w_in, b_forget, lambda_q1, lambda_k1, lambda_q2, lambda_k2,
              subln_gain, sinks, w_up_a, w_up_b, w_up_c, w_o, final_gain):
    B, S, D = x.shape
    offsets = np.cumsum(SPLITS)[:-1].tolist()
    slopes_a = alibi_slopes(A_HEADS)
    slopes_b = alibi_slopes(B_HEADS)
    for l in range(DEPTH):
        h = rms_norm(x, norm_gain[l], RMS_EPS)
        proj = jnp.einsum('bsd,de->bse', h, w_in[l])
        (qa, ka, va, ga, qb, kb, vb, gb,
         qc, kc, vc, fc, gc, gm) = jnp.split(proj, offsets, axis=-1)

        lam_init = 0.8 - 0.6 * math.exp(-0.3 * l)
        lam = (jnp.exp(jnp.sum(lambda_q1[l].astype(jnp.float32) * lambda_k1[l].astype(jnp.float32)))
               - jnp.exp(jnp.sum(lambda_q2[l].astype(jnp.float32) * lambda_k2[l].astype(jnp.float32)))
               + lam_init)
        ya = diff_attention(qa.reshape(B, S, A_HEADS, 2, HEAD_DIM),
                            ka.reshape(B, S, A_HEADS, 2, HEAD_DIM),
                            va.reshape(B, S, A_HEADS, 2 * HEAD_DIM), lam, slopes_a)
        ya = (rms_norm(ya, subln_gain[l], SUBLN_EPS) * (1.0 - lam_init)).reshape(B, S, A_WIDTH)

        yb = sliding_window_attention(qb.reshape(B, S, B_HEADS, HEAD_DIM),
                                      kb.reshape(B, S, B_KV_HEADS, HEAD_DIM),
                                      vb.reshape(B, S, B_KV_HEADS, HEAD_DIM),
                                      sinks[l], slopes_b)

        logf = jax.nn.log_sigmoid(fc.astype(jnp.float32) + b_forget[l].astype(jnp.float32))
        yc = forgetting_attention(qc.reshape(B, S, C_HEADS, HEAD_DIM),
                                  kc.reshape(B, S, C_HEADS, HEAD_DIM),
                                  vc.reshape(B, S, C_HEADS, HEAD_DIM), logf)

        ua = jnp.einsum('bse,ed->bsd', ya * jax.nn.silu(ga), w_up_a[l])
        ub = jnp.einsum('bse,ed->bsd', yb * jax.nn.silu(gb), w_up_b[l])
        uc = jnp.einsum('bse,ed->bsd', yc * jax.nn.silu(gc), w_up_c[l])
        gates = jax.nn.sigmoid(gm.reshape(B, S, N_BRANCH, D))
        merged = gates[:, :, 0] * ua + gates[:, :, 1] * ub + gates[:, :, 2] * uc
        x = x + jnp.einsum('bsd,de->bse', merged, w_o[l])
    return rms_norm(x, final_gain, RMS_EPS)
```

```cpp
#include <hip/hip_runtime.h>
#include <hip/hip_cooperative_groups.h>
#include <cstdio>
#include <cstdint>
namespace cg = cooperative_groups;
namespace pg8 {
#define PG8_LAS __attribute__((address_space(3)))
typedef unsigned short bf16_t;
typedef short bf16x8 __attribute__((ext_vector_type(8)));
typedef float f32x4 __attribute__((ext_vector_type(4)));
typedef unsigned u32x4 __attribute__((ext_vector_type(4)));
constexpr int BM = 256, BK = 64, HALF = 128, HTB = HALF * BK * 2  , STAGE_BYTES = 8 * HTB, NXCD = 8, WGM = 8;

__host__ __device__ __forceinline__ int lds_byte(int r, int c) { const int st = (r >> 4) * 2 + (c >> 5), rr = r & 15, cc = c & 31, ob = rr * 64 + cc * 2; return st * 1024 + (ob ^ (((ob >> 9) & 1) << 5)); }
__host__ __device__ __forceinline__ void stage_rc(int b, int& R, int& C) { const int st = b / 1024, sb = b % 1024, swz = sb ^ (((sb >> 9) & 1) << 5); R = (st >> 1) * 16 + swz / 64; C = (st & 1) * 32 + (swz % 64) / 2; }
__host__ __device__ __forceinline__ int perm32(int rho) { const int n = rho >> 4, i = rho & 15; return 8 * (i >> 2) + 4 * n + (i & 3); }

struct Unit { int pm, pn; };
struct Gemm { const bf16_t* A; const bf16_t* Bt; int M, N, K; };

struct StaticOrder {
    int nM, nN, nwg, G, c;
    __host__ __device__ void init(int M, int N, int G_, int c_) { nM = M / BM; nN = N / BM; nwg = nM * nN; G = G_; c = c_; }
    __host__ __device__ bool next(int i, Unit& u) const {
        const long L = (long)i * G + c; if (L >= nwg) return false;
        int wgid = (int)L; { const int q = nwg / NXCD, r = nwg % NXCD, xcd = wgid % NXCD, off = wgid / NXCD; wgid = (xcd < r ? xcd * (q + 1) : r * (q + 1) + (xcd - r) * q) + off; }
        const int nig = WGM * nN, gid = wgid / nig, fm = gid * WGM, gsz = (nM - fm) < WGM ? (nM - fm) : WGM;
        u.pm = fm + ((wgid % nig) % gsz); u.pn = (wgid % nig) / gsz; return true;
    }
    __device__ __forceinline__ void a_ready(const Unit&) const {}
    __device__ __forceinline__ void done(const Unit&) const {}
};

typedef float f32x2p_t __attribute__((ext_vector_type(2))); typedef __bf16 bf16x2p_t __attribute__((ext_vector_type(2)));
__device__ __forceinline__ unsigned cvt_pk_bf16(float lo, float hi) { const f32x2p_t v = {lo, hi}; return __builtin_bit_cast(unsigned, __builtin_convertvector(v, bf16x2p_t)); }
typedef float f32x2 __attribute__((ext_vector_type(2)));
__device__ __forceinline__ f32x2 gelu_pk(f32x2 v) {
    const f32x2 av = __builtin_elementwise_abs(v), d = av * 0.2316418882f + 1.0f;
    f32x2 t; t.x = __builtin_amdgcn_rcpf(d.x); t.y = __builtin_amdgcn_rcpf(d.y);
    f32x2 q = t * 0.5307027145f + (-0.7265760135f); q = q * t + 0.7107068705f; q = q * t + (-0.142248368f); q = q * t + 0.127414796f; q = q * t;
    const f32x2 s = (v * v) * (-0.72134752044f);
    f32x2 e; e.x = __builtin_amdgcn_exp2f(s.x); e.y = __builtin_amdgcn_exp2f(s.y);
    const f32x2 m = v * (q * e), r = v - m;
    f32x2 o; o.x = v.x < 0.f ? m.x : r.x; o.y = v.y < 0.f ? m.y : r.y; return o;
}

template <int ACT  > struct EpiBf16 {
    static constexpr bool PERM = true, AFTER_DRAIN = false; static_assert(ACT == 0 || ACT == 1, "EpiBf16: ACT is 0 (none) or 1 (gelu_pk)");
    bf16_t* O; int ldc; const float* bias; int split_cols; size_t split_stride; float scale0;
    __device__ __forceinline__ void operator()(const f32x4 (&acc)[2][2][4][2], const Unit& u, int wr, int wc, int fr, int fq) const {
        const int row0 = u.pm * BM + wr * 64 + fr; int colt = u.pn * BM; bf16_t* base = O;
        float sc = 1.f; if (split_cols) { const int t = colt / split_cols; base += (size_t)t * split_stride; colt -= t * split_cols; if (t == 0) sc = scale0; }
        const int col0 = colt + wc * 32 + 8 * fq, bcol0 = u.pn * BM + wc * 32 + 8 * fq;
        f32x4 bv[2][2];
#pragma unroll
        for (int bj = 0; bj < 2; ++bj)
#pragma unroll
            for (int n = 0; n < 2; ++n) bv[bj][n] = bias ? *(const f32x4*)(bias + bcol0 + bj * HALF + 4 * n) : (f32x4){0.f, 0.f, 0.f, 0.f};
#pragma unroll
        for (int ai = 0; ai < 2; ++ai)
#pragma unroll
            for (int m = 0; m < 4; ++m) { bf16_t* rowp = base + (size_t)(row0 + ai * HALF + m * 16) * ldc + col0;
#pragma unroll
                for (int bj = 0; bj < 2; ++bj) { f32x4 v0 = acc[ai][bj][m][0] + bv[bj][0], v1 = acc[ai][bj][m][1] + bv[bj][1];
                    if (ACT == 1) { f32x2 a = gelu_pk((f32x2){v0[0], v0[1]}), b = gelu_pk((f32x2){v0[2], v0[3]}), c = gelu_pk((f32x2){v1[0], v1[1]}), d = gelu_pk((f32x2){v1[2], v1[3]});
                        v0 = (f32x4){a.x, a.y, b.x, b.y}; v1 = (f32x4){c.x, c.y, d.x, d.y}; }
                    v0 = v0 * sc; v1 = v1 * sc; u32x4 w; w.x = cvt_pk_bf16(v0[0], v0[1]); w.y = cvt_pk_bf16(v0[2], v0[3]); w.z = cvt_pk_bf16(v1[0], v1[1]); w.w = cvt_pk_bf16(v1[2], v1[3]);
                    *(u32x4*)(rowp + bj * HALF) = w; } }
    }
};
typedef unsigned u32x2 __attribute__((ext_vector_type(2)));
__device__ __forceinline__ float sigm(float g) { return __builtin_amdgcn_rcpf(1.0f + __expf(-g)); }
__device__ __forceinline__ float bflo(unsigned w) { return __uint_as_float(w << 16); }
__device__ __forceinline__ float bfhi(unsigned w) { return __uint_as_float(w & 0xffff0000u); }
struct EpiG1a {
    static constexpr bool PERM = true, AFTER_DRAIN = false;
    bf16_t* O; unsigned* kabs;
    __device__ __forceinline__ void operator()(const f32x4 (&acc)[2][2][4][2], const Unit& u, int wr, int wc, int fr, int fq) const {
        bf16_t* rowp = O + (size_t)(u.pm * BM + wr * 64 + fr) * 2816 + u.pn * BM + wc * 32 + 8 * fq;
        float mx = 0.f;
#pragma unroll
        for (int ai = 0; ai < 2; ++ai)
#pragma unroll
            for (int m = 0; m < 4; ++m)
#pragma unroll
                for (int bj = 0; bj < 2; ++bj) { const f32x4 v0 = acc[ai][bj][m][0], v1 = acc[ai][bj][m][1]; u32x4 w;
                    mx = fmaxf(mx, fmaxf(fmaxf(fabsf(v0[0]), fabsf(v0[1])), fmaxf(fabsf(v0[2]), fabsf(v0[3]))));
                    mx = fmaxf(mx, fmaxf(fmaxf(fabsf(v1[0]), fabsf(v1[1])), fmaxf(fabsf(v1[2]), fabsf(v1[3]))));
                    w.x = cvt_pk_bf16(v0[0], v0[1]); w.y = cvt_pk_bf16(v0[2], v0[3]); w.z = cvt_pk_bf16(v1[0], v1[1]); w.w = cvt_pk_bf16(v1[2], v1[3]);
                    *(u32x4*)(rowp + (size_t)(ai * HALF + m * 16) * 2816 + bj * HALF) = w; }
#pragma unroll
        for (int o = 1; o < 64; o <<= 1) mx = fmaxf(mx, __shfl_xor(mx, o));
        if ((fr | fq) == 0) atomicMax(kabs + u.pm * 11 + u.pn, __float_as_uint(mx * 1.01f));
    }
};
struct EpiG1b {
    static constexpr bool PERM = true, AFTER_DRAIN = false;
    bf16_t* Y; bf16_t* GM;
    typedef float f32x2e __attribute__((ext_vector_type(2)));
    template <bool CLAMP> static __device__ __forceinline__ f32x2e sig2(f32x2e g) {
        const f32x2e t = g * (-1.4426950408889634f); f32x2e e; e.x = __builtin_amdgcn_exp2f(t.x); e.y = __builtin_amdgcn_exp2f(t.y);
        if (CLAMP) { e.x = fminf(e.x, 1e20f); e.y = fminf(e.y, 1e20f); }
        const f32x2e d = e + 1.0f; f32x2e r; r.x = __builtin_amdgcn_rcpf(d.x); r.y = __builtin_amdgcn_rcpf(d.y); return r;
    }
    __device__ __forceinline__ void operator()(const f32x4 (&acc)[2][2][4][2], const Unit& u, int wr, int wc, int fr, int fq) const {
        if (u.pn < 6) {
            bf16_t* rowp = Y + (size_t)(u.pm * BM + wr * 64 + fr) * 1536 + u.pn * BM + wc * 32 + 8 * fq;
#pragma unroll
            for (int ai = 0; ai < 2; ++ai) {
                u32x4 yv[4][2];
#pragma unroll
                for (int m = 0; m < 4; ++m)
#pragma unroll
                    for (int bj = 0; bj < 2; ++bj) yv[m][bj] = *(const u32x4*)(rowp + (size_t)(ai * HALF + m * 16) * 1536 + bj * HALF);
#pragma unroll
                for (int m = 0; m < 4; ++m)
#pragma unroll
                    for (int bj = 0; bj < 2; ++bj) { const f32x4 g0 = acc[ai][bj][m][0], g1 = acc[ai][bj][m][1]; const u32x4 y = yv[m][bj]; u32x4 w;
                        { const f32x2e g = {g0[0], g0[1]}; const f32x2e z = ((f32x2e){bflo(y.x), bfhi(y.x)} * g) * sig2<false>(g); w.x = cvt_pk_bf16(z.x, z.y); }
                        { const f32x2e g = {g0[2], g0[3]}; const f32x2e z = ((f32x2e){bflo(y.y), bfhi(y.y)} * g) * sig2<false>(g); w.y = cvt_pk_bf16(z.x, z.y); }
                        { const f32x2e g = {g1[0], g1[1]}; const f32x2e z = ((f32x2e){bflo(y.z), bfhi(y.z)} * g) * sig2<false>(g); w.z = cvt_pk_bf16(z.x, z.y); }
                        { const f32x2e g = {g1[2], g1[3]}; const f32x2e z = ((f32x2e){bflo(y.w), bfhi(y.w)} * g) * sig2<false>(g); w.w = cvt_pk_bf16(z.x, z.y); }
                        *(u32x4*)(rowp + (size_t)(ai * HALF + m * 16) * 1536 + bj * HALF) = w; }
                asm volatile("" ::: "memory");
            }
        } else {
            bf16_t* rowp = GM + (size_t)(u.pm * BM + wr * 64 + fr) * 3072 + (u.pn - 6) * BM + wc * 32 + 8 * fq;
#pragma unroll
            for (int ai = 0; ai < 2; ++ai)
#pragma unroll
                for (int m = 0; m < 4; ++m)
#pragma unroll
                    for (int bj = 0; bj < 2; ++bj) { const f32x4 g0 = acc[ai][bj][m][0], g1 = acc[ai][bj][m][1]; u32x4 w;
                        { const f32x2e r = sig2<true>((f32x2e){g0[0], g0[1]}); w.x = cvt_pk_bf16(r.x, r.y); }
                        { const f32x2e r = sig2<true>((f32x2e){g0[2], g0[3]}); w.y = cvt_pk_bf16(r.x, r.y); }
                        { const f32x2e r = sig2<true>((f32x2e){g1[0], g1[1]}); w.z = cvt_pk_bf16(r.x, r.y); }
                        { const f32x2e r = sig2<true>((f32x2e){g1[2], g1[3]}); w.w = cvt_pk_bf16(r.x, r.y); }
                        *(u32x4*)(rowp + (size_t)(ai * HALF + m * 16) * 3072 + bj * HALF) = w; }
        }
    }
};
struct EpiG3a {
    static constexpr bool PERM = true, AFTER_DRAIN = false;
    const bf16_t* GM; bf16_t* MG;
    __device__ __forceinline__ void mid(f32x4 (&acc)[2][2][4][2], const Unit& u, int which, int wr, int wc, int fr, int fq) const {
        asm volatile("" : "+v"(fr), "+v"(fq));
        const bf16_t* rp0 = GM + (size_t)(u.pm * BM + wr * 64 + fr) * 3072 + which * 1024 + u.pn * BM + wc * 32 + 8 * fq;
#define G3A_LD(A_, B_, q_) do { _Pragma("unroll") for (int mm = 0; mm < 2; ++mm) _Pragma("unroll") for (int bj = 0; bj < 2; ++bj) { \
            const bf16_t* rp = rp0 + (size_t)(((q_) >> 1) * HALF + (((q_) & 1) * 2 + mm) * 16) * 3072 + bj * HALF; A_[mm][bj] = *(const u32x4*)rp; B_[mm][bj] = *(const u32x4*)(rp + 1024); } } while (0)
#define G3A_MUL(A_, B_, q_) do { _Pragma("unroll") for (int mm = 0; mm < 2; ++mm) _Pragma("unroll") for (int bj = 0; bj < 2; ++bj) { const u32x4 x = A_[mm][bj], y = B_[mm][bj]; f32x4 r0, r1; \
            r0[0] = bflo(x.x) * __builtin_amdgcn_rcpf(bflo(y.x)); r0[1] = bfhi(x.x) * __builtin_amdgcn_rcpf(bfhi(y.x)); r0[2] = bflo(x.y) * __builtin_amdgcn_rcpf(bflo(y.y)); r0[3] = bfhi(x.y) * __builtin_amdgcn_rcpf(bfhi(y.y)); \
            r1[0] = bflo(x.z) * __builtin_amdgcn_rcpf(bflo(y.z)); r1[1] = bfhi(x.z) * __builtin_amdgcn_rcpf(bfhi(y.z)); r1[2] = bflo(x.w) * __builtin_amdgcn_rcpf(bflo(y.w)); r1[3] = bfhi(x.w) * __builtin_amdgcn_rcpf(bfhi(y.w)); \
            acc[(q_) >> 1][bj][((q_) & 1) * 2 + mm][0] *= r0; acc[(q_) >> 1][bj][((q_) & 1) * 2 + mm][1] *= r1; } } while (0)
        u32x4 a0[2][2], b0[2][2], a1[2][2], b1[2][2];
        G3A_LD(a0, b0, 0); G3A_LD(a1, b1, 1); asm volatile("" ::: "memory");
        G3A_MUL(a0, b0, 0); G3A_LD(a0, b0, 2); asm volatile("" ::: "memory");
        G3A_MUL(a1, b1, 1); G3A_LD(a1, b1, 3); asm volatile("" ::: "memory");
        G3A_MUL(a0, b0, 2); G3A_MUL(a1, b1, 3); asm volatile("" ::: "memory");
#undef G3A_LD
#undef G3A_MUL
    }
    __device__ __forceinline__ void operator()(const f32x4 (&acc)[2][2][4][2], const Unit& u, int wr, int wc, int fr, int fq) const {
        const int row0 = u.pm * BM + wr * 64 + fr, col0 = u.pn * BM + wc * 32 + 8 * fq;
#define G3A_ROW(q_, mm_) ((size_t)(row0 + ((q_) >> 1) * HALF + (((q_) & 1) * 2 + (mm_)) * 16))
#define G3A_LDS(S_, q_) do { _Pragma("unroll") for (int mm = 0; mm < 2; ++mm) _Pragma("unroll") for (int bj = 0; bj < 2; ++bj) S_[mm][bj] = *(const u32x4*)(GM + G3A_ROW(q_, mm) * 3072 + 2048 + col0 + bj * HALF); } while (0)
#define G3A_ST(S_, q_) do { _Pragma("unroll") for (int mm = 0; mm < 2; ++mm) _Pragma("unroll") for (int bj = 0; bj < 2; ++bj) { const u32x4 sg = S_[mm][bj]; \
            const f32x4 v0 = acc[(q_) >> 1][bj][((q_) & 1) * 2 + mm][0], v1 = acc[(q_) >> 1][bj][((q_) & 1) * 2 + mm][1]; u32x4 w; \
            w.x = cvt_pk_bf16(v0[0] * bflo(sg.x), v0[1] * bfhi(sg.x)); w.y = cvt_pk_bf16(v0[2] * bflo(sg.y), v0[3] * bfhi(sg.y)); \
            w.z = cvt_pk_bf16(v1[0] * bflo(sg.z), v1[1] * bfhi(sg.z)); w.w = cvt_pk_bf16(v1[2] * bflo(sg.w), v1[3] * bfhi(sg.w)); \
            *(u32x4*)(MG + G3A_ROW(q_, mm) * 1024 + col0 + bj * HALF) = w; } } while (0)
        u32x4 s0[2][2], s1[2][2];
        G3A_LDS(s0, 0); G3A_LDS(s1, 1); asm volatile("" ::: "memory");
        G3A_ST(s0, 0); G3A_LDS(s0, 2); asm volatile("" ::: "memory");
        G3A_ST(s1, 1); G3A_LDS(s1, 3); asm volatile("" ::: "memory");
        G3A_ST(s0, 2); G3A_ST(s1, 3); asm volatile("" ::: "memory");
#undef G3A_ROW
#undef G3A_LDS
#undef G3A_ST
    }
};
struct EpiG3b {
    static constexpr bool PERM = false, AFTER_DRAIN = false;
    const float* xin; float* xout;
    __device__ __forceinline__ void operator()(const f32x4 (&acc)[2][2][4][2], const Unit& u, int wr, int wc, int fr, int fq) const {
        const int row0 = u.pm * BM + wr * 64 + fr, col0 = u.pn * BM + wc * 32 + 4 * fq;
#define G3B_OFF(q_, mm_, bj_, n_) ((size_t)(row0 + ((q_) >> 1) * HALF + (((q_) & 1) * 2 + (mm_)) * 16) * 1024 + col0 + (bj_) * HALF + (n_) * 16)
#define G3B_LD(dst, q_) do { _Pragma("unroll") for (int mm = 0; mm < 2; ++mm) _Pragma("unroll") for (int bj = 0; bj < 2; ++bj) _Pragma("unroll") for (int n = 0; n < 2; ++n) dst[mm][bj][n] = *(const f32x4*)(xin + G3B_OFF(q_, mm, bj, n)); } while (0)
#define G3B_ST(src, q_) do { _Pragma("unroll") for (int mm = 0; mm < 2; ++mm) _Pragma("unroll") for (int bj = 0; bj < 2; ++bj) _Pragma("unroll") for (int n = 0; n < 2; ++n) \
            *(f32x4*)(xout + G3B_OFF(q_, mm, bj, n)) = src[mm][bj][n] + acc[(q_) >> 1][bj][((q_) & 1) * 2 + mm][n]; } while (0)
        f32x4 xa[2][2][2], xb[2][2][2];
        G3B_LD(xa, 0); G3B_LD(xb, 1); asm volatile("" ::: "memory");
        G3B_ST(xa, 0); G3B_LD(xa, 2); asm volatile("" ::: "memory");
        G3B_ST(xb, 1); G3B_LD(xb, 3); asm volatile("" ::: "memory");
        G3B_ST(xa, 2); G3B_ST(xb, 3); asm volatile("" ::: "memory");
#undef G3B_OFF
#undef G3B_LD
#undef G3B_ST
    }
};

template <class Epi, class Sched, bool ALIGN_EPI = false, bool SP2 = false, bool HOOK = false>
__device__ __forceinline__ void gemm_phase(PG8_LAS unsigned char* lds, const Gemm g, const Sched& S, const Epi& E) {
    int tid_ = threadIdx.x; asm volatile("" : "+v"(tid_));
    const int tid = tid_, wid = __builtin_amdgcn_readfirstlane(tid >> 6), lane = tid & 63, wr = wid >> 2, wc = wid & 3, fr = lane & 15, fq = lane >> 4;
    const int K = g.K, nt = K / BK;
    unsigned voffA[2], voffB[2];
#pragma unroll
    for (int i = 0; i < 2; ++i) { int R, C; stage_rc(tid * 16 + i * 8192, R, C); const int Rb = Epi::PERM ? ((R & ~31) + perm32(R & 31)) : R;
        voffA[i] = (unsigned)(R * K + C) * 2u; voffB[i] = (unsigned)(Rb * K + C) * 2u; }
    const size_t kstep = (size_t)(BK * 2);
    const size_t hstep = (size_t)HALF * K * 2;
    const size_t tstep = 2 * hstep;
    const unsigned ldsw = (unsigned)wid * 1024u;
    const int aoff = lds_byte(wr * 64 + fr, fq * 8), boff = lds_byte(wc * 32 + fr, fq * 8);
#define PG8_SA(b, h) (((b) * 2 + (h)) * HTB)
#define PG8_SB(b, h) ((4 + (b) * 2 + (h)) * HTB)
#define PG8_STAGE(bufoff, gbase, voff) do { _Pragma("unroll") for (int _i = 0; _i < 2; ++_i) \
        __builtin_amdgcn_global_load_lds((const unsigned*)((const char*)(gbase) + (voff)[_i]), (PG8_LAS unsigned*)(lds + (bufoff) + ldsw + _i * 8192), 16, 0, 0); } while (0)
#define PG8_LDA(dst, b, h) do { _Pragma("unroll") for (int m = 0; m < 4; ++m) _Pragma("unroll") for (int k = 0; k < 2; ++k) dst[m][k] = *(const PG8_LAS bf16x8*)(lds + PG8_SA(b, h) + aoff + m * 2048 + k * 1024); } while (0)
#define PG8_LDB(dst, b, h) do { _Pragma("unroll") for (int n = 0; n < 2; ++n) _Pragma("unroll") for (int k = 0; k < 2; ++k) dst[n][k] = *(const PG8_LAS bf16x8*)(lds + PG8_SB(b, h) + boff + n * 2048 + k * 1024); } while (0)
#define PG8_MMA(ai, bj, At, Bt) do { __builtin_amdgcn_s_setprio(1); _Pragma("unroll") for (int m = 0; m < 4; ++m) _Pragma("unroll") for (int n = 0; n < 2; ++n) _Pragma("unroll") for (int k = 0; k < 2; ++k) \
        acc[ai][bj][m][n] = __builtin_amdgcn_mfma_f32_16x16x32_bf16(Bt[n][k], At[m][k], acc[ai][bj][m][n], 0, 0, 0); __builtin_amdgcn_s_setprio(0); } while (0)
#define PG8_WAIT_V(n) asm volatile("s_waitcnt vmcnt(" #n ")" ::: "memory")
#define PG8_WAIT_L(n) asm volatile("s_waitcnt lgkmcnt(" #n ")" ::: "memory")
#define PG8_BAR __builtin_amdgcn_s_barrier()
#define PG8_SCHED __builtin_amdgcn_sched_barrier(0)
    Unit cur, nxt; int ui = 0;
    if (!S.next(0, cur)) return;
    f32x4 acc[2][2][4][2];
#pragma unroll
    for (int a = 0; a < 2; ++a)
#pragma unroll
        for (int b = 0; b < 2; ++b)
#pragma unroll
            for (int m = 0; m < 4; ++m)
#pragma unroll
                for (int n = 0; n < 2; ++n) acc[a][b][m][n] = (f32x4){0.f, 0.f, 0.f, 0.f};
    bf16x8 At[4][2], B0[2][2], B1[2][2];
    const char* cA = (const char*)g.A + (size_t)cur.pm * tstep; const char* cB = (const char*)g.Bt + (size_t)cur.pn * tstep;
    S.a_ready(cur);
    if constexpr (SP2) {
        PG8_STAGE(PG8_SB(0, 0), cB, voffB); PG8_STAGE(PG8_SB(0, 1), cB + hstep, voffB); PG8_STAGE(PG8_SA(0, 0), cA, voffA); PG8_STAGE(PG8_SA(0, 1), cA + hstep, voffA);
        if (wr == 1) PG8_BAR;
        PG8_WAIT_V(2); PG8_BAR;
        PG8_STAGE(PG8_SB(1, 0), cB + kstep, voffB); PG8_STAGE(PG8_SA(1, 0), cA + kstep, voffA); PG8_STAGE(PG8_SB(1, 1), cB + hstep + kstep, voffB);
        PG8_WAIT_V(6); PG8_BAR;
    } else {
        PG8_STAGE(PG8_SB(0, 0), cB, voffB); PG8_STAGE(PG8_SA(0, 0), cA, voffA); PG8_STAGE(PG8_SB(0, 1), cB + hstep, voffB); PG8_STAGE(PG8_SA(0, 1), cA + hstep, voffA);
        if (wr == 1) PG8_BAR;
        PG8_WAIT_V(4); PG8_BAR;
        PG8_STAGE(PG8_SB(1, 0), cB + kstep, voffB); PG8_STAGE(PG8_SA(1, 0), cA + kstep, voffA); PG8_STAGE(PG8_SB(1, 1), cB + hstep + kstep, voffB);
        PG8_WAIT_V(6); PG8_BAR;
    }
    for (;;) {
        const bool has_next = S.next(ui + 1, nxt);
        const char* nA = has_next ? (const char*)g.A + (size_t)nxt.pm * tstep : cA; const char* nB = has_next ? (const char*)g.Bt + (size_t)nxt.pn * tstep : cB;
        for (int t = 0; t < nt; t += 2) {
            if constexpr (HOOK) { if (t == 8 || t == 16) E.mid(acc, cur, t >> 4, wr, wc, fr, fq); }
            const bool last = (t == nt - 2);
            const char* a1 = cA + (size_t)(t + 1) * kstep;
            const char* a2 = last ? nA : cA + (size_t)(t + 2) * kstep; const char* b2 = last ? nB : cB + (size_t)(t + 2) * kstep;
            const char* a3 = a2 + kstep; const char* b3 = b2 + kstep;
            if (last && has_next) S.a_ready(nxt);
            if constexpr (SP2) {
            PG8_LDB(B0, 0, 0); PG8_LDB(B1, 0, 1); PG8_SCHED; PG8_LDA(At, 0, 0); PG8_STAGE(PG8_SA(1, 1), a1 + hstep, voffA);
            PG8_WAIT_V(8); PG8_WAIT_L(0); PG8_BAR; PG8_MMA(0, 0, At, B0); PG8_MMA(0, 1, At, B1); PG8_BAR; PG8_SCHED;
            PG8_LDA(At, 0, 1); PG8_STAGE(PG8_SB(0, 0), b2, voffB); PG8_STAGE(PG8_SB(0, 1), b2 + hstep, voffB); PG8_STAGE(PG8_SA(0, 0), a2, voffA);
            PG8_WAIT_V(8); PG8_WAIT_L(0); PG8_BAR; PG8_MMA(1, 0, At, B0); PG8_MMA(1, 1, At, B1); PG8_BAR; PG8_SCHED;
            PG8_LDB(B0, 1, 0); PG8_LDB(B1, 1, 1); PG8_SCHED; PG8_LDA(At, 1, 0); PG8_STAGE(PG8_SA(0, 1), a2 + hstep, voffA);
            PG8_WAIT_V(8); PG8_WAIT_L(0); PG8_BAR; PG8_MMA(0, 0, At, B0); PG8_MMA(0, 1, At, B1); PG8_BAR; PG8_SCHED;
            PG8_LDA(At, 1, 1); PG8_STAGE(PG8_SB(1, 0), b3, voffB); PG8_STAGE(PG8_SB(1, 1), b3 + hstep, voffB); PG8_STAGE(PG8_SA(1, 0), a3, voffA);
            PG8_WAIT_V(8); PG8_WAIT_L(0); PG8_BAR; PG8_MMA(1, 0, At, B0); PG8_MMA(1, 1, At, B1); PG8_BAR; PG8_SCHED;
            } else {
            PG8_LDB(B0, 0, 0); PG8_SCHED; PG8_LDA(At, 0, 0); PG8_STAGE(PG8_SA(1, 1), a1 + hstep, voffA);
            PG8_WAIT_L(8); PG8_BAR; PG8_WAIT_L(0); PG8_MMA(0, 0, At, B0); PG8_BAR; PG8_SCHED;
            PG8_LDB(B1, 0, 1); PG8_STAGE(PG8_SB(0, 0), b2, voffB);
            PG8_BAR; PG8_WAIT_L(0); PG8_MMA(0, 1, At, B1); PG8_BAR;
            PG8_LDA(At, 0, 1); PG8_STAGE(PG8_SA(0, 0), a2, voffA);
            PG8_BAR; PG8_WAIT_L(0); PG8_MMA(1, 0, At, B0); PG8_BAR; PG8_SCHED;
            PG8_STAGE(PG8_SB(0, 1), b2 + hstep, voffB);
            PG8_WAIT_V(6); PG8_BAR; PG8_MMA(1, 1, At, B1); PG8_BAR;
            PG8_LDB(B0, 1, 0); PG8_SCHED; PG8_LDA(At, 1, 0); PG8_STAGE(PG8_SA(0, 1), a2 + hstep, voffA);
            PG8_WAIT_L(8); PG8_BAR; PG8_WAIT_L(0); PG8_MMA(0, 0, At, B0); PG8_BAR; PG8_SCHED;
            PG8_LDB(B1, 1, 1); PG8_STAGE(PG8_SB(1, 0), b3, voffB);
            PG8_BAR; PG8_WAIT_L(0); PG8_MMA(0, 1, At, B1); PG8_BAR;
            PG8_LDA(At, 1, 1); PG8_STAGE(PG8_SA(1, 0), a3, voffA);
            PG8_BAR; PG8_WAIT_L(0); PG8_MMA(1, 0, At, B0); PG8_BAR; PG8_SCHED;
            PG8_STAGE(PG8_SB(1, 1), b3 + hstep, voffB);
            PG8_WAIT_V(6); PG8_BAR; PG8_MMA(1, 1, At, B1); PG8_BAR;
            }
        }
        if constexpr (ALIGN_EPI) { if (wr == 0) PG8_BAR; }
        if constexpr (!Epi::AFTER_DRAIN) { E(acc, cur, wr, wc, fr, fq); S.done(cur); }
        if (!has_next) break;
#pragma unroll
        for (int a = 0; a < 2; ++a)
#pragma unroll
            for (int b = 0; b < 2; ++b)
#pragma unroll
                for (int m = 0; m < 4; ++m)
#pragma unroll
                    for (int n = 0; n < 2; ++n) acc[a][b][m][n] = (f32x4){0.f, 0.f, 0.f, 0.f};
        cur = nxt; cA = nA; cB = nB; ++ui;
        if constexpr (ALIGN_EPI) { if (wr == 1) PG8_BAR; }
    }
    PG8_WAIT_V(0);
    if constexpr (!ALIGN_EPI) { if (wr == 0) PG8_BAR; }
    PG8_BAR;
    if constexpr (Epi::AFTER_DRAIN) { E.fused(acc, cur, wr, wc, fr, fq, lds, wid, lane); S.done(cur); }
#undef PG8_SA
#undef PG8_SB
#undef PG8_STAGE
#undef PG8_LDA
#undef PG8_LDB
#undef PG8_MMA
#undef PG8_WAIT_V
#undef PG8_WAIT_L
#undef PG8_BAR
#undef PG8_SCHED
}
}
#define LAS __attribute__((address_space(3)))
typedef unsigned short bf16;
typedef short bf16x8 __attribute__((ext_vector_type(8)));
typedef float f32x4 __attribute__((ext_vector_type(4)));
typedef float f32x16 __attribute__((ext_vector_type(16)));
typedef unsigned u32x4 __attribute__((ext_vector_type(4)));
typedef unsigned u32x2 __attribute__((ext_vector_type(2)));

constexpr int M = 32768, D = 1024, SEQ = 4096, DIN = 8456, NW1 = 8704, DEPTH = 4;
constexpr int N1A = 2816, N1V = 1280, N1B = 4608;
constexpr float LOG2E = 1.4426950408889634f, QSCALE = 0.125f * 1.4426950408889634f;
constexpr size_t MiB = 1u << 20;
constexpr size_t WS_LOGF = 1 * MiB, WS_W1 = 2 * MiB, WS_WUP = 70 * MiB, WS_WO = 82 * MiB, WS_XB = 90 * MiB, WS_Y = 154 * MiB, WS_QK = 250 * MiB, WS_VT = 426 * MiB, WS_GM = 250 * MiB, WS_END = 506 * MiB;
constexpr int LDS_BYTES = 147456;
constexpr int NPHASE = 1 + 6 * DEPTH;
#ifndef ENMASK
#define ENMASK 0xff
#endif
#define EN(k) (((ENMASK) >> (k)) & 1)
#ifndef MK_N_LAUNCHES
#define MK_N_LAUNCHES 1
#endif

__device__ __forceinline__ float wave_sum(float v) {
#pragma unroll
    for (int o = 1; o < 64; o <<= 1) v += __shfl_xor(v, o);
    return v;
}
__device__ __forceinline__ float xhalf_max(float v) { auto rr = __builtin_amdgcn_permlane32_swap(__float_as_uint(v), __float_as_uint(v), false, false); return fmaxf(__uint_as_float(rr[0]), __uint_as_float(rr[1])); }
__device__ __forceinline__ float xhalf_sum(float v) { auto rr = __builtin_amdgcn_permlane32_swap(__float_as_uint(v), __float_as_uint(v), false, false); return __uint_as_float(rr[0]) + __uint_as_float(rr[1]); }
__device__ __forceinline__ unsigned pk2(float lo, float hi) { return pg8::cvt_pk_bf16(lo, hi); }
__device__ __forceinline__ int crow(int r, int hi) { return (r & 3) + 8 * (r >> 2) + 4 * hi; }

__device__ __forceinline__ void transpose_item(const float* __restrict__ src, int src_pitch, int src_col0, int k0, bf16* __restrict__ dst, int dst_pitch, int dst_row0, int dst_col0,
                                               float scale, const float* __restrict__ gain, bool zero, LAS float* scr, int lane) {
#pragma unroll
    for (int i = 0; i < 8; ++i) { const int kk = 8 * i + (lane >> 3), n4 = 4 * (lane & 7);
        f32x4 v = {0.f, 0.f, 0.f, 0.f};
        if (!zero) { v = *(const f32x4*)(src + (size_t)(k0 + kk) * src_pitch + src_col0 + n4); float g = scale; if (gain) g *= gain[k0 + kk]; v = v * g; }
        scr[kk * 33 + n4] = v[0]; scr[kk * 33 + n4 + 1] = v[1]; scr[kk * 33 + n4 + 2] = v[2]; scr[kk * 33 + n4 + 3] = v[3]; }
    asm volatile("s_waitcnt lgkmcnt(0)" ::: "memory");
    const int c = lane & 7;
#pragma unroll
    for (int j = 0; j < 4; ++j) { const int n = (lane >> 3) + 8 * j; const LAS float* s = scr + (8 * c) * 33 + n;
        u32x4 o; o.x = pk2(s[0 * 33], s[1 * 33]); o.y = pk2(s[2 * 33], s[3 * 33]); o.z = pk2(s[4 * 33], s[5 * 33]); o.w = pk2(s[6 * 33], s[7 * 33]);
        *(u32x4*)(dst + (size_t)(dst_row0 + n) * dst_pitch + dst_col0 + k0 + 8 * c) = o; }
    asm volatile("s_waitcnt lgkmcnt(0)" ::: "memory");
}
__device__ __forceinline__ bool w1_map(int r, int& src, float& scale) {
    scale = 1.f;
    if (r < 512) { src = r; scale = QSCALE; return true; }
    if (r < 1024) { src = 512 + (r - 512); return true; }
    if (r < 1536) { src = 2048 + (r - 1024); scale = QSCALE; return true; }
    if (r < 2048) { src = 3328 + (r - 1536); scale = QSCALE; return true; }
    if (r < 2560) { src = 3840 + (r - 2048); return true; }
    if (r < 2688) { src = 2560 + (r - 2560); return true; }
    if (r < 2816) { src = 0; return false; }
    if (r < 3328) { src = 1024 + (r - 2816); return true; }
    if (r < 3840) { src = 4352 + (r - 3328); return true; }
    if (r < 3968) { src = 2688 + (r - 3840); return true; }
    if (r < 4096) { src = 0; return false; }
    if (r < 4608) { src = 1536 + (r - 4096); return true; }
    if (r < 5120) { src = 2816 + (r - 4608); return true; }
    if (r < 5632) { src = 4872 + (r - 5120); return true; }
    src = 5384 + (r - 5632); return true;
}

#define XB_TMO      128
#define XB_XCNT(j)  (256  + 64 * (j))
#define XB_XSUB(j)  (1280 + 64 * (j))
#define XB_XGEN(j)  (2304 + 64 * (j))
#define XB_TOP      3328
#define XB_TOPGEN   3392
#define XCD_BAR_WORDS 3456
#define XB_SPIN_CAP (1u << 18)

__device__ __forceinline__ unsigned xb_ld(unsigned* p)              { return __hip_atomic_load(p, __ATOMIC_RELAXED, __HIP_MEMORY_SCOPE_AGENT); }
__device__ __forceinline__ unsigned xb_add(unsigned* p, unsigned v) { return __hip_atomic_fetch_add(p, v, __ATOMIC_RELAXED, __HIP_MEMORY_SCOPE_AGENT); }
__device__ __forceinline__ unsigned xb_xcc_id() { return (unsigned)__builtin_amdgcn_s_getreg((3 << 11) | 20) & 0xFu; }
#define XB_SPIN(cond, bar) do { unsigned _sp = 0; while (cond) { __builtin_amdgcn_s_sleep(1); \
    if ((++_sp & 255u) == 0u) { if (xb_ld(&(bar)[XB_TMO])) break; if (_sp > XB_SPIN_CAP) { atomicAdd(&(bar)[XB_TMO], 1u); break; } } } } while (0)

struct XcdBarrier {
    unsigned* bar; unsigned x;
    volatile LAS unsigned* st;
};

__device__ __forceinline__ XcdBarrier xcd_barrier_post(unsigned* bar, volatile LAS unsigned* st) {
    XcdBarrier b; b.bar = bar; b.x = xb_xcc_id(); b.st = st;
    if (threadIdx.x == 0) (void)xb_add(&bar[XB_XCNT(b.x)], 1u);
    return b;
}
__device__ __forceinline__ void xcd_barrier_complete(unsigned* bar, unsigned x, unsigned& nloc, unsigned& nx) {
    const unsigned G = gridDim.x * gridDim.y * gridDim.z;
    unsigned sum, cnt, mine, sp = 0u;
    for (;;) {
        sum = 0u; cnt = 0u; mine = 0u;
#pragma unroll
        for (unsigned j = 0; j < 16; ++j) { const unsigned c = xb_ld(&bar[XB_XCNT(j)]); sum += c; cnt += (c > 0u) ? 1u : 0u; mine = (j == x) ? c : mine; }
        if (sum == G) break;
        __builtin_amdgcn_s_sleep(1);
        if ((++sp & 255u) == 0u) { if (xb_ld(&bar[XB_TMO])) break; if (sp > XB_SPIN_CAP) { atomicAdd(&bar[XB_TMO], 1u); break; } }
    }
    nloc = mine > 0u ? mine : 1u; nx = cnt > 0u ? cnt : 1u;
}

__device__ __forceinline__ void xcd_barrier(const XcdBarrier& b) {
    asm volatile("s_waitcnt vmcnt(0)" ::: "memory");
    __syncthreads();
    if (threadIdx.x == 0) {
        unsigned* bar = b.bar;
        __builtin_amdgcn_s_waitcnt(0);
        unsigned nloc = b.st[0], nx = b.st[1];
        if (nloc == 0u) { xcd_barrier_complete(bar, b.x, nloc, nx); b.st[0] = nloc; b.st[1] = nx; }
        const unsigned old = xb_add(&bar[XB_XSUB(b.x)], 1u);
        const unsigned gen = old / nloc;
        if (old + 1u == (gen + 1u) * nloc) {
            __builtin_amdgcn_fence(__ATOMIC_RELEASE, "agent");
            asm volatile("s_waitcnt vmcnt(0)" ::: "memory");
            const unsigned og = xb_add(&bar[XB_TOP], 1u);
            const unsigned tg = og / nx;
            if (og + 1u == (tg + 1u) * nx) xb_add(&bar[XB_TOPGEN], 1u);
            else XB_SPIN(xb_ld(&bar[XB_TOPGEN]) == tg, bar);
            __builtin_amdgcn_fence(__ATOMIC_ACQUIRE, "agent");
            xb_add(&bar[XB_XGEN(b.x)], 1u);
            asm volatile("s_waitcnt vmcnt(0)" ::: "memory");
        } else {
            XB_SPIN(xb_ld(&bar[XB_XGEN(b.x)]) == gen, bar);
            __builtin_amdgcn_fence(__ATOMIC_ACQUIRE, "agent");
            asm volatile("s_waitcnt vmcnt(0)" ::: "memory");
        }
    }
    __syncthreads();
}

constexpr size_t WS_BAR = 65536;
struct Args { const float* in[15]; float* out; unsigned char* ws; int ph_lo, ph_hi; };

__device__ __forceinline__ void norm_pass(LAS unsigned char* lds, const Args& a, const float* xsrc, int layer, int gw, int ngw) {
    int tid_ = threadIdx.x; asm volatile("" : "+v"(tid_));
    const int tid = tid_, lane = tid & 63;
    LAS float* Wt = (LAS float*)lds;
    const float* wsrc = a.in[2] + (size_t)layer * D * DIN + 4864; const float* gain = a.in[1] + layer * D;
    for (int d = tid; d < D; d += 512) { const f32x4 w0 = *(const f32x4*)(wsrc + (size_t)d * DIN), w1 = *(const f32x4*)(wsrc + (size_t)d * DIN + 4); const float g = gain[d];
        Wt[0 * D + d] = w0[0] * g; Wt[1 * D + d] = w0[1] * g; Wt[2 * D + d] = w0[2] * g; Wt[3 * D + d] = w0[3] * g;
        Wt[4 * D + d] = w1[0] * g; Wt[5 * D + d] = w1[1] * g; Wt[6 * D + d] = w1[2] * g; Wt[7 * D + d] = w1[3] * g; }
    __syncthreads();
    bf16* XB = (bf16*)(a.ws + WS_XB); float* logf = (float*)(a.ws + WS_LOGF);
    if (gw * 64 + lane < 128 * 11) ((float*)a.ws)[gw * 64 + lane] = 0.f;
    if (gw == 0 && lane < 24) ((unsigned*)(a.ws + 32768))[64 * lane] = 0u;
    const float bj = a.in[3][layer * 8 + (lane & 7)];
    f32x4 vn[4];
    if (gw < M) { const f32x4* xr = (const f32x4*)(xsrc + (size_t)gw * D) + lane;
#pragma unroll
        for (int j = 0; j < 4; ++j) vn[j] = xr[64 * j]; }
    for (int row = gw; row < M; row += ngw) {
        f32x4 v[4]; float ss = 0.f;
#pragma unroll
        for (int j = 0; j < 4; ++j) { v[j] = vn[j]; ss += (v[j][0] * v[j][0] + v[j][1] * v[j][1]) + (v[j][2] * v[j][2] + v[j][3] * v[j][3]); }
        if (row + ngw < M) { const f32x4* xr = (const f32x4*)(xsrc + (size_t)(row + ngw) * D) + lane;
#pragma unroll
            for (int j = 0; j < 4; ++j) vn[j] = xr[64 * j]; }
        const float r = 1.0f / sqrtf(wave_sum(ss) * (1.f / D) + 1e-6f);
        unsigned long long* o8 = (unsigned long long*)(XB + (size_t)row * D) + lane;
#pragma unroll
        for (int j = 0; j < 4; ++j) o8[64 * j] = (unsigned long long)pk2(v[j][0] * r, v[j][1] * r) | ((unsigned long long)pk2(v[j][2] * r, v[j][3] * r) << 32);
        float fc[8];
#pragma unroll
        for (int jj = 0; jj < 8; ++jj) { float s = 0.f;
#pragma unroll
            for (int j = 0; j < 4; ++j) { const f32x4 w = *(const LAS f32x4*)(Wt + jj * D + 256 * j + 4 * lane); s += (v[j][0] * w[0] + v[j][1] * w[1]) + (v[j][2] * w[2] + v[j][3] * w[3]); }
            fc[jj] = wave_sum(s); }
        const int js = lane & 7;
        float f = js == 0 ? fc[0] : js == 1 ? fc[1] : js == 2 ? fc[2] : js == 3 ? fc[3] : js == 4 ? fc[4] : js == 5 ? fc[5] : js == 6 ? fc[6] : fc[7];
        f = f * r + bj;
        const float lf = fminf(f, 0.f) - log1pf(expf(-fabsf(f)));
        if (lane < 8) logf[(size_t)row * 8 + lane] = lf;
    }
    __syncthreads();
}
__device__ __forceinline__ void final_pass(const Args& a, int gw, int ngw) {
    int lane_ = threadIdx.x & 63; asm volatile("" : "+v"(lane_)); const int lane = lane_; const float* fg = a.in[14];
    f32x4 g[4];
#pragma unroll
    for (int j = 0; j < 4; ++j) g[j] = *((const f32x4*)fg + lane + 64 * j);
    f32x4 vn[4];
    if (gw < M) { const f32x4* xn = (const f32x4*)(a.out + (size_t)gw * D) + lane;
#pragma unroll
        for (int j = 0; j < 4; ++j) vn[j] = xn[64 * j]; }
    for (int row = gw; row < M; row += ngw) {
        f32x4* xr = (f32x4*)(a.out + (size_t)row * D) + lane;
        f32x4 v[4]; float ss = 0.f;
#pragma unroll
        for (int j = 0; j < 4; ++j) { v[j] = vn[j]; ss += (v[j][0] * v[j][0] + v[j][1] * v[j][1]) + (v[j][2] * v[j][2] + v[j][3] * v[j][3]); }
        if (row + ngw < M) { const f32x4* xn = (const f32x4*)(a.out + (size_t)(row + ngw) * D) + lane;
#pragma unroll
            for (int j = 0; j < 4; ++j) vn[j] = xn[64 * j]; }
        const float r = 1.0f / sqrtf(wave_sum(ss) * (1.f / D) + 1e-6f);
#pragma unroll
        for (int j = 0; j < 4; ++j) xr[64 * j] = v[j] * r * g[j];
    }
}

template <int MODE> struct AttCfg {
    static constexpr int DV = MODE == 0 ? 128 : 64, ROWS = MODE == 2 ? 256 : MODE == 1 ? 64 : 128, KROWB = MODE == 0 ? 256 : 128, KSTR = KROWB + 16, VSTR = 136, NC = DV / 32;
    static constexpr int NKL = KROWB / 128, NVL = DV / 64, KCH = KROWB / 16;
    static constexpr int KB_OFF = 0, VB_OFF = 34816, BI_OFF = MODE == 1 ? 71680 : 69632, WS_OFF = 70144, VOTE_OFF = 71168, XC_OFF = 71680;
    static constexpr bool REV = MODE != 1;
};
#define ATT_SB() __builtin_amdgcn_sched_barrier(0)
template <int MODE>
__device__ __forceinline__ void att_tile(LAS unsigned char* lds, int buf, int kv0, int wq0, int r32, int hi, int mapi, const bf16x8 (&qr)[4], f32x16 (&O)[AttCfg<MODE>::NC], float& mrun, float& lsum, LAS float* wsf, bool fixed = false  ) {
    typedef AttCfg<MODE> C; constexpr int NC = C::NC;
    const float NEG = -__builtin_inff();
    f32x16 p0, p1; bf16x8 kf[8]; u32x4 vf[2 * NC];
    const LAS unsigned char* vb = lds + C::VB_OFF + buf * C::DV * C::VSTR + r32 * C::VSTR + hi * 8;
    ATT_SB();
    { const LAS float* bp = (const LAS float*)(lds + C::BI_OFF) + (MODE == 1 ? mapi * 128 : 0) + buf * 64 + 4 * hi;
      const LAS unsigned char* kb = lds + C::KB_OFF + buf * 64 * C::KSTR + (MODE == 0 ? mapi * 128 : 0) + hi * 16 + r32 * C::KSTR;
#pragma unroll
      for (int i = 0; i < 4; ++i) { const f32x4 b0 = *(const LAS f32x4*)(bp + 8 * i), b1 = *(const LAS f32x4*)(bp + 32 + 8 * i);
#pragma unroll
          for (int k = 0; k < 4; ++k) { p0[4 * i + k] = b0[k]; p1[4 * i + k] = b1[k]; } }
#pragma unroll
      for (int d0 = 0; d0 < 4; ++d0) { kf[2 * d0] = *(const LAS bf16x8*)(kb + d0 * 32); kf[2 * d0 + 1] = *(const LAS bf16x8*)(kb + 32 * C::KSTR + d0 * 32); }
 }
    ATT_SB();
#pragma unroll
    for (int d0 = 0; d0 < 4; ++d0) { p0 = __builtin_amdgcn_mfma_f32_32x32x16_bf16(kf[2 * d0], qr[d0], p0, 0, 0, 0); p1 = __builtin_amdgcn_mfma_f32_32x32x16_bf16(kf[2 * d0 + 1], qr[d0], p1, 0, 0, 0); }
    ATT_SB();
#pragma unroll
    for (int j = 0; j < 2; ++j)
#pragma unroll
        for (int c = 0; c < NC; ++c) { const u32x2 lo = *(const LAS u32x2*)(vb + c * 32 * C::VSTR + j * 32), hh = *(const LAS u32x2*)(vb + c * 32 * C::VSTR + j * 32 + 16); vf[j * NC + c] = (u32x4){lo.x, lo.y, hh.x, hh.y}; }
    ATT_SB();
    const bool full = (kv0 + 63 <= wq0) && (MODE != 1 || (wq0 + 31 - kv0) < 128);
    if (!full) { const int qpos = wq0 + r32;
#pragma unroll
        for (int r = 0; r < 16; ++r) { const int kv = kv0 + crow(r, hi); bool ok0 = kv <= qpos, ok1 = kv + 32 <= qpos;
            if (MODE == 1) { ok0 = ok0 && (qpos - kv < 128); ok1 = ok1 && (qpos - kv - 32 < 128); }
            p0[r] = ok0 ? p0[r] : NEG; p1[r] = ok1 ? p1[r] : NEG; } }
    float msafe = mrun, alpha = 1.0f;
    if (!fixed) {
        float mxa = __builtin_fmaxf(p0[0], p0[1]), mxb = __builtin_fmaxf(p1[0], p1[1]);
#pragma unroll
        for (int r = 2; r < 16; r += 2) { mxa = __builtin_fmaxf(__builtin_fmaxf(mxa, p0[r]), p0[r + 1]); mxb = __builtin_fmaxf(__builtin_fmaxf(mxb, p1[r]), p1[r + 1]); }
        float mx = __builtin_fmaxf(mxa, mxb);
        mx = xhalf_max(mx);
        const float mnew = fmaxf(mrun, mx); msafe = (mnew == NEG) ? 0.f : mnew;
        alpha = __builtin_amdgcn_exp2f(mrun - msafe); mrun = mnew;
    }
    float ps = 0.f;
#pragma unroll
    for (int r = 0; r < 16; ++r) { p0[r] = __builtin_amdgcn_exp2f(p0[r] - msafe); p1[r] = __builtin_amdgcn_exp2f(p1[r] - msafe); ps += p0[r] + p1[r]; }
    lsum = lsum * alpha + ps;
    if (!fixed) {
    if (__any(alpha != 1.0f)) {
        if (hi == 0) wsf[r32] = alpha;
        asm volatile("s_waitcnt lgkmcnt(0)" ::: "memory");
#pragma unroll
        for (int i = 0; i < 4; ++i) { const f32x4 av = *(const LAS f32x4*)(wsf + 8 * i + 4 * hi);
#pragma unroll
            for (int c = 0; c < NC; ++c)
#pragma unroll
                for (int k = 0; k < 4; ++k) O[c][4 * i + k] *= av[k]; }
        asm volatile("s_waitcnt lgkmcnt(0)" ::: "memory");
    }
    }
    bf16x8 pa[4];
    { u32x4 w;
      w.x = pk2(p0[0], p0[1]); w.y = pk2(p0[2], p0[3]); w.z = pk2(p0[4], p0[5]); w.w = pk2(p0[6], p0[7]); pa[0] = __builtin_bit_cast(bf16x8, w);
      w.x = pk2(p0[8], p0[9]); w.y = pk2(p0[10], p0[11]); w.z = pk2(p0[12], p0[13]); w.w = pk2(p0[14], p0[15]); pa[1] = __builtin_bit_cast(bf16x8, w);
      w.x = pk2(p1[0], p1[1]); w.y = pk2(p1[2], p1[3]); w.z = pk2(p1[4], p1[5]); w.w = pk2(p1[6], p1[7]); pa[2] = __builtin_bit_cast(bf16x8, w);
      w.x = pk2(p1[8], p1[9]); w.y = pk2(p1[10], p1[11]); w.z = pk2(p1[12], p1[13]); w.w = pk2(p1[14], p1[15]); pa[3] = __builtin_bit_cast(bf16x8, w); }
    ATT_SB();
    u32x4 vg[2 * NC];
#pragma unroll
    for (int j = 0; j < 2; ++j)
#pragma unroll
        for (int c = 0; c < NC; ++c) { const u32x2 lo = *(const LAS u32x2*)(vb + c * 32 * C::VSTR + (j + 2) * 32), hh = *(const LAS u32x2*)(vb + c * 32 * C::VSTR + (j + 2) * 32 + 16); vg[j * NC + c] = (u32x4){lo.x, lo.y, hh.x, hh.y}; }
    ATT_SB();
#pragma unroll
    for (int j = 0; j < 2; ++j)
#pragma unroll
        for (int c = 0; c < NC; ++c) O[c] = __builtin_amdgcn_mfma_f32_32x32x16_bf16(pa[j], __builtin_bit_cast(bf16x8, vf[j * NC + c]), O[c], 0, 0, 0);
    ATT_SB();
#pragma unroll
    for (int j = 0; j < 2; ++j)
#pragma unroll
        for (int c = 0; c < NC; ++c) O[c] = __builtin_amdgcn_mfma_f32_32x32x16_bf16(pa[j + 2], __builtin_bit_cast(bf16x8, vg[j * NC + c]), O[c], 0, 0, 0);
    ATT_SB();
}

template <int MODE>
__device__ __forceinline__ void attn_unit(LAS unsigned char* lds, const bf16* __restrict__ QK, const bf16* __restrict__ VT, bf16* __restrict__ Y, const float* __restrict__ logf,
                                          int b, int h, int qblk, float sl2, float sink2, float lam, float subfac, const float* __restrict__ subg, float kinf) {
    typedef AttCfg<MODE> C;
    constexpr int DV = C::DV, ROWS = C::ROWS, KSTR = C::KSTR, VSTR = C::VSTR, NC = C::NC, NKL = C::NKL, NVL = C::NVL, KCH = C::KCH;
    constexpr int KB_OFF = C::KB_OFF, VB_OFF = C::VB_OFF, BI_OFF = C::BI_OFF, WS_OFF = C::WS_OFF, VOTE_OFF = C::VOTE_OFF, XC_OFF = C::XC_OFF;
    constexpr bool REV = C::REV;
    const float NEG = -__builtin_inff();
    int tid_ = threadIdx.x; asm volatile("" : "+v"(tid_));
    const int tid = tid_, lane = tid & 63, wid = __builtin_amdgcn_readfirstlane(tid >> 6), r32 = lane & 31, hi = lane >> 5;
    const int q0 = qblk * ROWS, wq0 = q0 + 32 * (MODE == 2 ? wid : MODE == 1 ? (wid & 1) : (wid & 3)), mapi = MODE == 2 ? 0 : MODE == 1 ? (wid >> 1) : (wid >> 2), heff = MODE == 1 ? h + mapi : h;
    const float sl2w = MODE == 1 ? sl2 * (1.0f / (float)(1 << mapi)) : sl2, sink2w = MODE == 1 ? subg[heff] * LOG2E : sink2;
    const size_t tok0 = (size_t)b * SEQ;
    const int qcol = MODE == 0 ? h * 128 + mapi * 64 : MODE == 1 ? 1024 + heff * 64 : 1536 + h * 64;
    const int kcol = MODE == 0 ? 512 + h * 128 : MODE == 1 ? 2560 + (h >> 2) * 64 : 2048 + h * 64;
    const int vrow = MODE == 0 ? h * 128 : MODE == 1 ? 1024 + (h >> 2) * 64 : 512 + h * 64;
    const int ycol = MODE == 0 ? h * 128 : MODE == 1 ? 512 + heff * 64 : 1024 + h * 64;
    const bf16* Kg = QK + tok0 * N1A + kcol;
    const bf16* Vg = VT + (size_t)vrow * M + tok0;
    bf16x8 qr[4];
    { const bf16* qp = QK + (tok0 + wq0 + r32) * N1A + qcol + hi * 8;
#pragma unroll
      for (int d0 = 0; d0 < 4; ++d0) qr[d0] = *(const bf16x8*)(qp + d0 * 16); }
    float qkb = 0.f;
    if (REV) {
#pragma unroll
        for (int d0 = 0; d0 < 4; ++d0) { const u32x4 w = __builtin_bit_cast(u32x4, qr[d0]);
            qkb += fabsf(pg8::bflo(w.x)) + fabsf(pg8::bfhi(w.x)) + fabsf(pg8::bflo(w.y)) + fabsf(pg8::bfhi(w.y)) + fabsf(pg8::bflo(w.z)) + fabsf(pg8::bfhi(w.z)) + fabsf(pg8::bflo(w.w)) + fabsf(pg8::bfhi(w.w)); }
        qkb = xhalf_sum(qkb) * kinf * 1.02f;
    }
    const int t_lo = MODE == 1 ? (q0 >= 128 ? (q0 - 128) / 64 : 0) : 0, t_hi = (q0 + ROWS) / 64;
    int kgoff[NKL], kloff[NKL], vgoff[NVL], vloff[NVL];
#pragma unroll
    for (int i = 0; i < NKL; ++i) { const int idx = tid + 512 * i, row = idx / KCH, ch = idx % KCH; kgoff[i] = row * N1A + ch * 8; kloff[i] = row * KSTR + ch * 16; }
#pragma unroll
    for (int i = 0; i < NVL; ++i) { const int idx = tid + 512 * i, row = idx >> 3, ch = idx & 7; vgoff[i] = row * M + ch * 8; vloff[i] = row * VSTR + ch * 16; }
    u32x4 kstA[NKL], vstA[NVL], kstB[NKL], vstB[NVL]; float lfA = 0.f, lfB = 0.f, carry = 0.f;
#define ATT_LOAD(t, KS, VS, LF) do { const char* kb_ = (const char*)Kg + (size_t)(t) * (64 * N1A * 2); const char* vb_ = (const char*)Vg + (size_t)(t) * 128; \
        _Pragma("unroll") for (int i_ = 0; i_ < NKL; ++i_) KS[i_] = *(const u32x4*)(kb_ + (unsigned)(2 * kgoff[i_])); \
        _Pragma("unroll") for (int i_ = 0; i_ < NVL; ++i_) VS[i_] = *(const u32x4*)(vb_ + (unsigned)(2 * vgoff[i_])); \
        if (MODE == 2 && wid == 0) LF = logf[(tok0 + (t) * 64 + lane) * 8 + h]; } while (0)
#define ATT_WRITE(t, bufi, KS, VS, LF) do { _Pragma("unroll") for (int i_ = 0; i_ < NKL; ++i_) *(LAS u32x4*)(lds + KB_OFF + (bufi) * 64 * KSTR + kloff[i_]) = KS[i_]; \
        _Pragma("unroll") for (int i_ = 0; i_ < NVL; ++i_) { LAS unsigned char* vp_ = lds + VB_OFF + (bufi) * DV * VSTR + vloff[i_]; *(LAS u32x2*)vp_ = (u32x2){VS[i_].x, VS[i_].y}; *(LAS u32x2*)(vp_ + 8) = (u32x2){VS[i_].z, VS[i_].w}; } \
        if ((MODE == 1 ? (wid & 1) : wid) == 0) { float bv_; if (MODE == 2) { float v_ = LF; _Pragma("unroll") for (int o_ = 1; o_ < 64; o_ <<= 1) { const float u_ = __shfl_down(v_, o_); if (lane + o_ < 64) v_ += u_; } \
                bv_ = (carry + v_ - LF) * LOG2E; carry += __shfl(v_, 0); } else bv_ = sl2w * (float)((t) * 64 + lane - q0); \
            ((LAS float*)(lds + BI_OFF))[(MODE == 1 ? mapi * 128 : 0) + (bufi) * 64 + lane] = bv_; } } while (0)
    float mrun = NEG, lsum = 0.f;
    if (MODE == 1) { mrun = sink2w + sl2w * (float)(wq0 + r32 - q0); lsum = hi == 0 ? 1.f : 0.f; }
    const bool dovote = (MODE != 0) || (sl2 * (float)(q0 + ROWS) >= 150.0f);
    const bool fixed = REV && !__any(qkb >= 66.0f);
    if (MODE == 0 && fixed) mrun = sl2 * (float)(wq0 + r32 - q0) + qkb - 20.0f;
    f32x16 O[NC];
#pragma unroll
    for (int c = 0; c < NC; ++c)
#pragma unroll
        for (int r = 0; r < 16; ++r) O[c][r] = 0.f;
    LAS float* wsf = (LAS float*)(lds + WS_OFF) + wid * 32;
    const int nt = t_hi - t_lo;
    LAS int* vote = (LAS int*)(lds + VOTE_OFF);
    bool wdone = false;
#define ATT_TILE(i_) (REV ? t_hi - 1 - (i_) : t_lo + (i_))
#define ATT_STEP(it_, KL, VL, LL, KW, VW, LW) do { const int t = ATT_TILE(it_), buf = (it_) & 1, kv0 = t * 64; \
        if ((it_) + 2 < nt) ATT_LOAD(ATT_TILE((it_) + 2), KL, VL, LL); \
        bool need = kv0 <= wq0 + 31; if (MODE == 1) need = need && (kv0 + 63 >= wq0 - 127); \
        if (MODE == 2 && fixed && need && kv0 == (wq0 & ~63)) mrun = ((const LAS float*)(lds + BI_OFF))[buf * 64 + (wq0 & 63) + r32] + qkb - 20.0f;     \
        if (need && !wdone) att_tile<MODE>(lds, buf, kv0, wq0, r32, hi, mapi, qr, O, mrun, lsum, wsf, fixed); \
        if (REV && dovote) { const float b0 = ((const LAS float*)(lds + BI_OFF))[buf * 64]; const int nd = __any(qkb + b0 > mrun - 150.0f) ? 1 : 0; if (lane == 0) vote[buf * 8 + wid] = nd; if (!nd) wdone = true; } \
        if ((it_) + 1 < nt) ATT_WRITE(ATT_TILE((it_) + 1), buf ^ 1, KW, VW, LW); \
        __syncthreads(); \
        if (REV && dovote) { const LAS int* vp = vote + buf * 8; const int any = (vp[0] | vp[1]) | (vp[2] | vp[3]) | (vp[4] | vp[5]) | (vp[6] | vp[7]); if (!any) stop = true; } } while (0)
    ATT_LOAD(ATT_TILE(0), kstA, vstA, lfA); ATT_WRITE(ATT_TILE(0), 0, kstA, vstA, lfA);
    if (nt > 1) ATT_LOAD(ATT_TILE(1), kstB, vstB, lfB);
    __syncthreads();
    bool stop = false;
    for (int it = 0; it < nt; it += 2) {
        ATT_STEP(it, kstA, vstA, lfA, kstB, vstB, lfB);
        if (stop || it + 1 >= nt) break;
        ATT_STEP(it + 1, kstB, vstB, lfB, kstA, vstA, lfA);
        if (stop) break;
    }
#undef ATT_LOAD
#undef ATT_WRITE
#undef ATT_TILE
#undef ATT_STEP
    const float lt = xhalf_sum(lsum);
    if (hi == 0) wsf[r32] = 1.0f / lt;
    asm volatile("s_waitcnt lgkmcnt(0)" ::: "memory");
    float il[16];
#pragma unroll
    for (int i = 0; i < 4; ++i) { const f32x4 av = *(const LAS f32x4*)(wsf + 8 * i + 4 * hi);
#pragma unroll
        for (int k = 0; k < 4; ++k) il[4 * i + k] = av[k]; }
    asm volatile("s_waitcnt lgkmcnt(0)" ::: "memory");
    if (MODE != 0) {
#pragma unroll
        for (int r = 0; r < 16; ++r) { bf16* yp = Y + (tok0 + wq0 + crow(r, hi)) * 1536 + ycol + r32;
#pragma unroll
            for (int c = 0; c < NC; ++c) yp[32 * c] = (bf16)(pk2(O[c][r] * il[r], 0.f) & 0xffffu); }
    } else {
        LAS float* xc = (LAS float*)(lds + XC_OFF) + (wid & 3) * 64 + lane;
        if (mapi == 1) {
#pragma unroll
            for (int c = 0; c < NC; ++c)
#pragma unroll
                for (int r = 0; r < 16; ++r) xc[(c * 16 + r) * 256] = O[c][r] * il[r];
        }
        __syncthreads();
        if (mapi == 0) {
            float ss[16];
#pragma unroll
            for (int r = 0; r < 16; ++r) { float s = 0.f;
#pragma unroll
                for (int c = 0; c < NC; ++c) { const float y = O[c][r] * il[r] - lam * xc[(c * 16 + r) * 256]; O[c][r] = y; s += y * y; }
                ss[r] = s; }
#pragma unroll
            for (int o = 1; o < 32; o <<= 1)
#pragma unroll
                for (int r = 0; r < 16; ++r) ss[r] += __shfl_xor(ss[r], o);
            float gsub[NC];
#pragma unroll
            for (int c = 0; c < NC; ++c) gsub[c] = subg[32 * c + r32] * subfac;
#pragma unroll
            for (int r = 0; r < 16; ++r) { const float inv = 1.0f / sqrtf(ss[r] * (1.f / 128.f) + 1e-5f); bf16* yp = Y + (tok0 + wq0 + crow(r, hi)) * 1536 + ycol + r32;
#pragma unroll
                for (int c = 0; c < NC; ++c) yp[32 * c] = (bf16)(pk2(O[c][r] * inv * gsub[c], 0.f) & 0xffffu); }
        }
    }
}

__device__ __forceinline__ void attn_phase(LAS unsigned char* lds, const Args& a, int layer, int vcu, int G) {
    int lane0_ = threadIdx.x & 63; asm volatile("" : "+v"(lane0_)); const int lane = lane0_;
    const bf16* QK = (const bf16*)(a.ws + WS_QK); const bf16* VT = (const bf16*)(a.ws + WS_VT); bf16* Y = (bf16*)(a.ws + WS_Y); const float* logf = (const float*)(a.ws + WS_LOGF);
    const float lam_init = 0.8f - 0.6f * expf(-0.3f * (float)layer);
    const float s1 = wave_sum(a.in[4][layer * 64 + lane] * a.in[5][layer * 64 + lane]), s2 = wave_sum(a.in[6][layer * 64 + lane] * a.in[7][layer * 64 + lane]);
    const float lam = __int_as_float(__builtin_amdgcn_readfirstlane(__float_as_int(expf(s1) - expf(s2) + lam_init))), subfac = 1.0f - lam_init;
    const float* subg = a.in[8] + layer * 128; const float* sinks = a.in[9] + layer * 8;
    const float* kabs = (const float*)a.ws;
    unsigned* qctr = (unsigned*)(a.ws + 32768);
    LAS unsigned* qslot = (LAS unsigned*)(lds + LDS_BYTES - 128);
    const int qb0 = (int)(xb_xcc_id() & 7u);
#define ATT_QUEUE(mix_, nunits_, ...) do { for (int qi = 0; qi < 8; ++qi) { const int b = (qb0 + qi) & 7; unsigned* ctr_ = qctr + 64 * ((mix_) * 8 + b); \
        if (threadIdx.x == 0) qslot[0] = atomicAdd(ctr_, 1u); \
        __syncthreads(); \
        unsigned u = (unsigned)__builtin_amdgcn_readfirstlane((int)qslot[0]); \
        while (u < (unsigned)(nunits_)) { \
            unsigned nxt_ = 0u; if (threadIdx.x == 0) nxt_ = atomicAdd(ctr_, 1u);     \
            __VA_ARGS__ \
            __syncthreads(); if (threadIdx.x == 0) qslot[0] = nxt_; __syncthreads(); \
            u = (unsigned)__builtin_amdgcn_readfirstlane((int)qslot[0]); } \
        __syncthreads(); } } while (0)
    ATT_QUEUE(0, 128, { const int s = 31 - (int)(u >> 2), h = 3 - (int)(u & 3u); const float sl2 = exp2f(-2.0f * (float)(h + 1)) * LOG2E;
        int l15_ = threadIdx.x & 15; asm volatile("" : "+v"(l15_)); float kinf = kabs[(b * 16 + l15_) * 11 + 2 + (h >> 1)];
        _Pragma("unroll") for (int o = 1; o < 16; o <<= 1) kinf = fmaxf(kinf, __shfl_xor(kinf, o));
        attn_unit<0>(lds, QK, VT, Y, logf, b, h, s, sl2, 0.f, lam, subfac, subg, kinf); });
    ATT_QUEUE(1, 128, { const int s = 15 - (int)(u >> 3), h = (int)(u & 7u);
        int l15_ = threadIdx.x & 15; asm volatile("" : "+v"(l15_)); float kinf = kabs[(b * 16 + l15_) * 11 + 8 + (h >> 2)];
        _Pragma("unroll") for (int o = 1; o < 16; o <<= 1) kinf = fmaxf(kinf, __shfl_xor(kinf, o));
        attn_unit<2>(lds, QK, VT, Y, logf, b, h, s, 0.f, 0.f, 0.f, 0.f, subg, kinf); });
    ATT_QUEUE(2, 128, { const int qb = (int)(u >> 1), h = 4 * (int)(u & 1u); const float sl2 = exp2f(-(float)(h + 1)) * LOG2E;
        attn_unit<1>(lds, QK, VT, Y, logf, b, h, qb, sl2, 0.f, 0.f, 0.f, sinks, 0.f); });
#undef ATT_QUEUE
}

__global__ void __launch_bounds__(512, 2) fwd_kernel(Args a) {
    extern __shared__ __attribute__((aligned(16))) unsigned char lds_raw[];
    LAS unsigned char* lds = (LAS unsigned char*)lds_raw;
    const int tid = threadIdx.x, wave = __builtin_amdgcn_readfirstlane(tid >> 6);
    const int G = gridDim.x, bx = blockIdx.x, vcu = (G % 8 == 0) ? (bx % 8) * (G / 8) + bx / 8 : bx;
    const int gw = vcu * 8 + wave, ngw = G * 8;
    const int lo = a.ph_lo, hi = a.ph_hi;
    bf16* W1T = (bf16*)(a.ws + WS_W1); bf16* WUPT = (bf16*)(a.ws + WS_WUP); bf16* WOT = (bf16*)(a.ws + WS_WO);
    bf16* XB = (bf16*)(a.ws + WS_XB); bf16* Yb = (bf16*)(a.ws + WS_Y); bf16* QK = (bf16*)(a.ws + WS_QK); bf16* VT = (bf16*)(a.ws + WS_VT); bf16* GM = (bf16*)(a.ws + WS_GM);
    volatile LAS unsigned* bst = (volatile LAS unsigned*)(lds + LDS_BYTES - 64);
    if (tid < 16) bst[tid] = 0u;
    __syncthreads();
    XcdBarrier bar; bar.bar = (unsigned*)(a.ws + WS_BAR); bar.x = 0; bar.st = bst;
#define IN(k) (lo <= (k) && (k) < hi)
#define SEAM(k) do { if (IN(k) && IN((k) + 1)) { if ((k) == 0) { cg::this_grid().sync(); bar = xcd_barrier_post((unsigned*)(a.ws + WS_BAR), bst); } else xcd_barrier(bar); } } while (0)
    if (IN(0) && bx == 0) { unsigned* bw = (unsigned*)(a.ws + WS_BAR); for (int i = tid; i < XCD_BAR_WORDS; i += 512) bw[i] = 0u; }
    if (EN(0) && IN(0)) {
        LAS float* scr = (LAS float*)(lds + wave * 16384);
        int lane_ = threadIdx.x & 63; asm volatile("" : "+v"(lane_)); const int lane = lane_;
        for (int it = gw; it < DEPTH * 5632; it += ngw) {
            const int l = it / 5632, r = it % 5632;
            if (r < 4352) { const int rb = r >> 4, kb = r & 15; int src; float sc; const bool ok = w1_map(32 * rb, src, sc);
                transpose_item(a.in[2] + (size_t)l * D * DIN, DIN, src, 64 * kb, W1T + (size_t)l * NW1 * D, D, 32 * rb, 0, sc, a.in[1] + l * D, !ok, scr, lane); }
            else if (r < 5120) { const int r2 = r - 4352, br = r2 >> 8, r3 = r2 & 255, kb = r3 >> 5, nb = r3 & 31;
                transpose_item((br == 0 ? a.in[10] : br == 1 ? a.in[11] : a.in[12]) + (size_t)l * 512 * D, D, 32 * nb, 64 * kb, WUPT + (size_t)l * D * 1536, 1536, 32 * nb, br * 512, 1.f, nullptr, false, scr, lane); }
            else { const int r2 = r - 5120, kb = r2 >> 5, nb = r2 & 31;
                transpose_item(a.in[13] + (size_t)l * D * D, D, 32 * nb, 64 * kb, WOT + (size_t)l * D * D, D, 32 * nb, 0, 1.f, nullptr, false, scr, lane); }
        }
        __syncthreads();
        norm_pass(lds, a, a.in[0], 0, gw, ngw);
    }
    SEAM(0);
    for (int l = 0; l < DEPTH; ++l) {
        const int pb = 1 + 6 * l;
        const bf16* W1l = W1T + (size_t)l * NW1 * D;
        if (EN(1) && IN(pb)) {
            { pg8::Gemm g{XB, W1l, M, N1A, D}; pg8::StaticOrder S; S.init(M, N1A, G, bx); pg8::EpiG1a E{QK, (unsigned*)a.ws};
              pg8::gemm_phase<pg8::EpiG1a, pg8::StaticOrder, true, true>(lds, g, S, E); }
            { pg8::Gemm g{W1l + (size_t)N1A * D, XB, N1V, M, D}; pg8::StaticOrder S; S.init(N1V, M, G, G - 1 - bx); pg8::EpiBf16<0> E{VT, M, nullptr, 0, 0, 1.f};
              pg8::gemm_phase<pg8::EpiBf16<0>, pg8::StaticOrder, true, true>(lds, g, S, E); }
        }
        SEAM(pb);
        if (EN(2) && IN(pb + 1)) attn_phase(lds, a, l, vcu, G);
        SEAM(pb + 1);
        if (EN(3) && IN(pb + 2)) { pg8::Gemm g{XB, W1l + (size_t)(N1A + N1V) * D, M, N1B, D}; pg8::StaticOrder S; S.init(M, N1B, G, bx); pg8::EpiG1b E{Yb, GM};
            pg8::gemm_phase<pg8::EpiG1b, pg8::StaticOrder, true, true>(lds, g, S, E); }
        SEAM(pb + 2);
        if (EN(4) && IN(pb + 3)) { pg8::Gemm g{Yb, WUPT + (size_t)l * D * 1536, M, D, 1536}; pg8::StaticOrder S; S.init(M, D, G, bx); pg8::EpiG3a E{GM, XB};
            pg8::gemm_phase<pg8::EpiG3a, pg8::StaticOrder, true, true, true>(lds, g, S, E); }
        SEAM(pb + 3);
        if (EN(5) && IN(pb + 4)) { pg8::Gemm g{XB, WOT + (size_t)l * D * D, M, D, D}; pg8::StaticOrder S; S.init(M, D, G, bx); pg8::EpiG3b E{l == 0 ? a.in[0] : a.out, a.out};
            pg8::gemm_phase<pg8::EpiG3b, pg8::StaticOrder, true, true>(lds, g, S, E); }
        SEAM(pb + 4);
        if (EN(6) && IN(pb + 5)) { if (l + 1 < DEPTH) norm_pass(lds, a, a.out, l + 1, gw, ngw); else final_pass(a, gw, ngw); }
        if (l + 1 < DEPTH) SEAM(pb + 5);
    }
#undef IN
#undef SEAM
}

extern "C" void kernel_launch(void* const* d_in, const int* in_sizes, int n_in, void* d_out, int out_size, void* d_ws, size_t ws_size, hipStream_t stream) {
    static int grid = 0;
    if (grid == 0) {
        if (n_in != 15 || out_size != M * D || ws_size < WS_END) { fprintf(stderr, "kernel_launch: unexpected shapes (n_in %d out %d ws %zu)\n", n_in, out_size, ws_size); grid = -1; return; }
        int dev = 0, cus = 0, per_cu = 0;
        hipGetDevice(&dev); hipDeviceGetAttribute(&cus, hipDeviceAttributeMultiprocessorCount, dev);
        hipFuncSetAttribute((const void*)fwd_kernel, hipFuncAttributeMaxDynamicSharedMemorySize, LDS_BYTES);
        if (hipOccupancyMaxActiveBlocksPerMultiprocessor(&per_cu, (const void*)fwd_kernel, 512, LDS_BYTES) != hipSuccess || per_cu < 1) per_cu = 1;
        (void)hipGetLastError();
        grid = cus * per_cu;
    }
    if (grid < 0) return;
    Args a{};
    for (int i = 0; i < 15; ++i) a.in[i] = (const float*)d_in[i];
    a.out = (float*)d_out; a.ws = (unsigned char*)d_ws;
#if MK_N_LAUNCHES == 1
    a.ph_lo = 0; a.ph_hi = NPHASE;
    void* args[] = {&a};
    hipError_t e = hipLaunchCooperativeKernel((const void*)fwd_kernel, dim3(grid), dim3(512), args, LDS_BYTES, stream);
    if (e != hipSuccess) fprintf(stderr, "cooperative launch failed: %s (grid %d)\n", hipGetErrorString(e), grid);
#else
    for (int p = 0; p < NPHASE; ++p) { a.ph_lo = p; a.ph_hi = p + 1; hipLaunchKernelGGL(fwd_kernel, dim3(grid), dim3(512), LDS_BYTES, stream, a); }
#endif
}
```

```cpp
#include <hip/hip_runtime.h>
#include <hip/hip_cooperative_groups.h>
#include <cstdio>
#include <cstdint>
namespace cg = cooperative_groups;
namespace pg8 {
#define PG8_LAS __attribute__((address_space(3)))
typedef unsigned short bf16_t;
typedef short bf16x8 __attribute__((ext_vector_type(8)));
typedef float f32x4 __attribute__((ext_vector_type(4)));
typedef unsigned u32x4 __attribute__((ext_vector_type(4)));
constexpr int BM = 256, BK = 64, HALF = 128, HTB = HALF * BK * 2  , STAGE_BYTES = 8 * HTB, NXCD = 8, WGM = 8;

__host__ __device__ __forceinline__ int lds_byte(int r, int c) { const int st = (r >> 4) * 2 + (c >> 5), rr = r & 15, cc = c & 31, ob = rr * 64 + cc * 2; return st * 1024 + (ob ^ (((ob >> 9) & 1) << 5)); }
__host__ __device__ __forceinline__ void stage_rc(int b, int& R, int& C) { const int st = b / 1024, sb = b % 1024, swz = sb ^ (((sb >> 9) & 1) << 5); R = (st >> 1) * 16 + swz / 64; C = (st & 1) * 32 + (swz % 64) / 2; }
__host__ __device__ __forceinline__ int perm32(int rho) { const int n = rho >> 4, i = rho & 15; return 8 * (i >> 2) + 4 * n + (i & 3); }

struct Unit { int pm, pn; };
struct Gemm { const bf16_t* A; const bf16_t* Bt; int M, N, K; };

struct StaticOrder {
    int nM, nN, nwg, G, c;
    __host__ __device__ void init(int M, int N, int G_, int c_) { nM = M / BM; nN = N / BM; nwg = nM * nN; G = G_; c = c_; }
    __host__ __device__ bool next(int i, Unit& u) const {
        const long L = (long)i * G + c; if (L >= nwg) return false;
        int wgid = (int)L; { const int q = nwg / NXCD, r = nwg % NXCD, xcd = wgid % NXCD, off = wgid / NXCD; wgid = (xcd < r ? xcd * (q + 1) : r * (q + 1) + (xcd - r) * q) + off; }
        const int nig = WGM * nN, gid = wgid / nig, fm = gid * WGM, gsz = (nM - fm) < WGM ? (nM - fm) : WGM;
        u.pm = fm + ((wgid % nig) % gsz); u.pn = (wgid % nig) / gsz; return true;
    }
    __device__ __forceinline__ void a_ready(const Unit&) const {}
    __device__ __forceinline__ void done(const Unit&) const {}
};

typedef float f32x2p_t __attribute__((ext_vector_type(2))); typedef __bf16 bf16x2p_t __attribute__((ext_vector_type(2)));
__device__ __forceinline__ unsigned cvt_pk_bf16(float lo, float hi) { const f32x2p_t v = {lo, hi}; return __builtin_bit_cast(unsigned, __builtin_convertvector(v, bf16x2p_t)); }
typedef float f32x2 __attribute__((ext_vector_type(2)));
__device__ __forceinline__ f32x2 gelu_pk(f32x2 v) {
    const f32x2 av = __builtin_elementwise_abs(v), d = av * 0.2316418882f + 1.0f;
    f32x2 t; t.x = __builtin_amdgcn_rcpf(d.x); t.y = __builtin_amdgcn_rcpf(d.y);
    f32x2 q = t * 0.5307027145f + (-0.7265760135f); q = q * t + 0.7107068705f; q = q * t + (-0.142248368f); q = q * t + 0.127414796f; q = q * t;
    const f32x2 s = (v * v) * (-0.72134752044f);
    f32x2 e; e.x = __builtin_amdgcn_exp2f(s.x); e.y = __builtin_amdgcn_exp2f(s.y);
    const f32x2 m = v * (q * e), r = v - m;
    f32x2 o; o.x = v.x < 0.f ? m.x : r.x; o.y = v.y < 0.f ? m.y : r.y; return o;
}

template <int ACT  > struct EpiBf16 {
    static constexpr bool PERM = true, AFTER_DRAIN = false; static_assert(ACT == 0 || ACT == 1, "EpiBf16: ACT is 0 (none) or 1 (gelu_pk)");
    bf16_t* O; int ldc; const float* bias; int split_cols; size_t split_stride; float scale0;
    __device__ __forceinline__ void operator()(const f32x4 (&acc)[2][2][4][2], const Unit& u, int wr, int wc, int fr, int fq) const {
        const int row0 = u.pm * BM + wr * 64 + fr; int colt = u.pn * BM; bf16_t* base = O;
        float sc = 1.f; if (split_cols) { const int t = colt / split_cols; base += (size_t)t * split_stride; colt -= t * split_cols; if (t == 0) sc = scale0; }
        const int col0 = colt + wc * 32 + 8 * fq, bcol0 = u.pn * BM + wc * 32 + 8 * fq;
        f32x4 bv[2][2];
#pragma unroll
        for (int bj = 0; bj < 2; ++bj)
#pragma unroll
            for (int n = 0; n < 2; ++n) bv[bj][n] = bias ? *(const f32x4*)(bias + bcol0 + bj * HALF + 4 * n) : (f32x4){0.f, 0.f, 0.f, 0.f};
#pragma unroll
        for (int ai = 0; ai < 2; ++ai)
#pragma unroll
            for (int m = 0; m < 4; ++m) { bf16_t* rowp = base + (size_t)(row0 + ai * HALF + m * 16) * ldc + col0;
#pragma unroll
                for (int bj = 0; bj < 2; ++bj) { f32x4 v0 = acc[ai][bj][m][0] + bv[bj][0], v1 = acc[ai][bj][m][1] + bv[bj][1];
                    if (ACT == 1) { f32x2 a = gelu_pk((f32x2){v0[0], v0[1]}), b = gelu_pk((f32x2){v0[2], v0[3]}), c = gelu_pk((f32x2){v1[0], v1[1]}), d = gelu_pk((f32x2){v1[2], v1[3]});
                        v0 = (f32x4){a.x, a.y, b.x, b.y}; v1 = (f32x4){c.x, c.y, d.x, d.y}; }
                    v0 = v0 * sc; v1 = v1 * sc; u32x4 w; w.x = cvt_pk_bf16(v0[0], v0[1]); w.y = cvt_pk_bf16(v0[2], v0[3]); w.z = cvt_pk_bf16(v1[0], v1[1]); w.w = cvt_pk_bf16(v1[2], v1[3]);
                    *(u32x4*)(rowp + bj * HALF) = w; } }
    }
};
typedef unsigned u32x2 __attribute__((ext_vector_type(2)));
__device__ __forceinline__ float sigm(float g) { return __builtin_amdgcn_rcpf(1.0f + __expf(-g)); }
__device__ __forceinline__ float bflo(unsigned w) { return __uint_as_float(w << 16); }
__device__ __forceinline__ float bfhi(unsigned w) { return __uint_as_float(w & 0xffff0000u); }
struct EpiG1a {
    static constexpr bool PERM = true, AFTER_DRAIN = false;
    bf16_t* O; unsigned* kabs;
    __device__ __forceinline__ void operator()(const f32x4 (&acc)[2][2][4][2], const Unit& u, int wr, int wc, int fr, int fq) const {
        bf16_t* rowp = O + (size_t)(u.pm * BM + wr * 64 + fr) * 2816 + u.pn * BM + wc * 32 + 8 * fq;
        float mx = 0.f;
#pragma unroll
        for (int ai = 0; ai < 2; ++ai)
#pragma unroll
            for (int m = 0; m < 4; ++m)
#pragma unroll
                for (int bj = 0; bj < 2; ++bj) { const f32x4 v0 = acc[ai][bj][m][0], v1 = acc[ai][bj][m][1]; u32x4 w;
                    mx = fmaxf(mx, fmaxf(fmaxf(fabsf(v0[0]), fabsf(v0[1])), fmaxf(fabsf(v0[2]), fabsf(v0[3]))));
                    mx = fmaxf(mx, fmaxf(fmaxf(fabsf(v1[0]), fabsf(v1[1])), fmaxf(fabsf(v1[2]), fabsf(v1[3]))));
                    w.x = cvt_pk_bf16(v0[0], v0[1]); w.y = cvt_pk_bf16(v0[2], v0[3]); w.z = cvt_pk_bf16(v1[0], v1[1]); w.w = cvt_pk_bf16(v1[2], v1[3]);
                    *(u32x4*)(rowp + (size_t)(ai * HALF + m * 16) * 2816 + bj * HALF) = w; }
#pragma unroll
        for (int o = 1; o < 64; o <<= 1) mx = fmaxf(mx, __shfl_xor(mx, o));
        if ((fr | fq) == 0) atomicMax(kabs + u.pm * 11 + u.pn, __float_as_uint(mx * 1.01f));
    }
};
struct EpiG1b {
    static constexpr bool PERM = true, AFTER_DRAIN = false;
    bf16_t* Y; bf16_t* GM;
    typedef float f32x2e __attribute__((ext_vector_type(2)));
    template <bool CLAMP> static __device__ __forceinline__ f32x2e sig2(f32x2e g) {
        const f32x2e t = g * (-1.4426950408889634f); f32x2e e; e.x = __builtin_amdgcn_exp2f(t.x); e.y = __builtin_amdgcn_exp2f(t.y);
        if (CLAMP) { e.x = fminf(e.x, 1e20f); e.y = fminf(e.y, 1e20f); }
        const f32x2e d = e + 1.0f; f32x2e r; r.x = __builtin_amdgcn_rcpf(d.x); r.y = __builtin_amdgcn_rcpf(d.y); return r;
    }
    __device__ __forceinline__ void operator()(const f32x4 (&acc)[2][2][4][2], const Unit& u, int wr, int wc, int fr, int fq) const {
        if (u.pn < 6) {
            bf16_t* rowp = Y + (size_t)(u.pm * BM + wr * 64 + fr) * 1536 + u.pn * BM + wc * 32 + 8 * fq;
#define G1B_P(q_, mm_, bj_) (rowp + (size_t)(((q_) >> 1) * HALF + (((q_) & 1) * 2 + (mm_)) * 16) * 1536 + (bj_) * HALF)
#define G1B_LD(Y_, q_) do { _Pragma("unroll") for (int mm = 0; mm < 2; ++mm) _Pragma("unroll") for (int bj = 0; bj < 2; ++bj) Y_[mm][bj] = *(const u32x4*)G1B_P(q_, mm, bj); } while (0)
#define G1B_ST(Y_, q_) do { _Pragma("unroll") for (int mm = 0; mm < 2; ++mm) _Pragma("unroll") for (int bj = 0; bj < 2; ++bj) { \
                const f32x4 g0 = acc[(q_) >> 1][bj][((q_) & 1) * 2 + mm][0], g1 = acc[(q_) >> 1][bj][((q_) & 1) * 2 + mm][1]; const u32x4 y = Y_[mm][bj]; u32x4 w; \
                { const f32x2e g = {g0[0], g0[1]}; const f32x2e z = ((f32x2e){bflo(y.x), bfhi(y.x)} * g) * sig2<false>(g); w.x = cvt_pk_bf16(z.x, z.y); } \
                { const f32x2e g = {g0[2], g0[3]}; const f32x2e z = ((f32x2e){bflo(y.y), bfhi(y.y)} * g) * sig2<false>(g); w.y = cvt_pk_bf16(z.x, z.y); } \
                { const f32x2e g = {g1[0], g1[1]}; const f32x2e z = ((f32x2e){bflo(y.z), bfhi(y.z)} * g) * sig2<false>(g); w.z = cvt_pk_bf16(z.x, z.y); } \
                { const f32x2e g = {g1[2], g1[3]}; const f32x2e z = ((f32x2e){bflo(y.w), bfhi(y.w)} * g) * sig2<false>(g); w.w = cvt_pk_bf16(z.x, z.y); } \
                *(u32x4*)G1B_P(q_, mm, bj) = w; } } while (0)
            u32x4 y0[2][2], y1[2][2];
            G1B_LD(y0, 0); G1B_LD(y1, 1); asm volatile("" ::: "memory");
            G1B_ST(y0, 0); G1B_LD(y0, 2); asm volatile("" ::: "memory");
            G1B_ST(y1, 1); G1B_LD(y1, 3); asm volatile("" ::: "memory");
            G1B_ST(y0, 2); G1B_ST(y1, 3); asm volatile("" ::: "memory");
#undef G1B_P
#undef G1B_LD
#undef G1B_ST
        } else {
            bf16_t* rowp = GM + (size_t)(u.pm * BM + wr * 64 + fr) * 3072 + (u.pn - 6) * BM + wc * 32 + 8 * fq;
#pragma unroll
            for (int ai = 0; ai < 2; ++ai)
#pragma unroll
                for (int m = 0; m < 4; ++m)
#pragma unroll
                    for (int bj = 0; bj < 2; ++bj) { const f32x4 g0 = acc[ai][bj][m][0], g1 = acc[ai][bj][m][1]; u32x4 w;
                        { const f32x2e r = sig2<true>((f32x2e){g0[0], g0[1]}); w.x = cvt_pk_bf16(r.x, r.y); }
                        { const f32x2e r = sig2<true>((f32x2e){g0[2], g0[3]}); w.y = cvt_pk_bf16(r.x, r.y); }
                        { const f32x2e r = sig2<true>((f32x2e){g1[0], g1[1]}); w.z = cvt_pk_bf16(r.x, r.y); }
                        { const f32x2e r = sig2<true>((f32x2e){g1[2], g1[3]}); w.w = cvt_pk_bf16(r.x, r.y); }
                        *(u32x4*)(rowp + (size_t)(ai * HALF + m * 16) * 3072 + bj * HALF) = w; }
        }
    }
};
struct EpiG3a {
    static constexpr bool PERM = true, AFTER_DRAIN = false;
    const bf16_t* GM; bf16_t* MG;
    __device__ __forceinline__ void mid(f32x4 (&acc)[2][2][4][2], const Unit& u, int which, int wr, int wc, int fr, int fq) const {
        asm volatile("" : "+v"(fr), "+v"(fq));
        const bf16_t* rp0 = GM + (size_t)(u.pm * BM + wr * 64 + fr) * 3072 + which * 1024 + u.pn * BM + wc * 32 + 8 * fq;
#define G3A_LD(A_, B_, q_) do { _Pragma("unroll") for (int mm = 0; mm < 2; ++mm) _Pragma("unroll") for (int bj = 0; bj < 2; ++bj) { \
            const bf16_t* rp = rp0 + (size_t)(((q_) >> 1) * HALF + (((q_) & 1) * 2 + mm) * 16) * 3072 + bj * HALF; A_[mm][bj] = *(const u32x4*)rp; B_[mm][bj] = *(const u32x4*)(rp + 1024); } } while (0)
#define G3A_MUL(A_, B_, q_) do { _Pragma("unroll") for (int mm = 0; mm < 2; ++mm) _Pragma("unroll") for (int bj = 0; bj < 2; ++bj) { const u32x4 x = A_[mm][bj], y = B_[mm][bj]; f32x4 r0, r1; \
            r0[0] = bflo(x.x) * __builtin_amdgcn_rcpf(bflo(y.x)); r0[1] = bfhi(x.x) * __builtin_amdgcn_rcpf(bfhi(y.x)); r0[2] = bflo(x.y) * __builtin_amdgcn_rcpf(bflo(y.y)); r0[3] = bfhi(x.y) * __builtin_amdgcn_rcpf(bfhi(y.y)); \
            r1[0] = bflo(x.z) * __builtin_amdgcn_rcpf(bflo(y.z)); r1[1] = bfhi(x.z) * __builtin_amdgcn_rcpf(bfhi(y.z)); r1[2] = bflo(x.w) * __builtin_amdgcn_rcpf(bflo(y.w)); r1[3] = bfhi(x.w) * __builtin_amdgcn_rcpf(bfhi(y.w)); \
            acc[(q_) >> 1][bj][((q_) & 1) * 2 + mm][0] *= r0; acc[(q_) >> 1][bj][((q_) & 1) * 2 + mm][1] *= r1; } } while (0)
        u32x4 a0[2][2], b0[2][2], a1[2][2], b1[2][2];
        G3A_LD(a0, b0, 0); G3A_LD(a1, b1, 1); asm volatile("" ::: "memory");
        G3A_MUL(a0, b0, 0); G3A_LD(a0, b0, 2); asm volatile("" ::: "memory");
        G3A_MUL(a1, b1, 1); G3A_LD(a1, b1, 3); asm volatile("" ::: "memory");
        G3A_MUL(a0, b0, 2); G3A_MUL(a1, b1, 3); asm volatile("" ::: "memory");
#undef G3A_LD
#undef G3A_MUL
    }
    __device__ __forceinline__ void operator()(const f32x4 (&acc)[2][2][4][2], const Unit& u, int wr, int wc, int fr, int fq) const {
        const int row0 = u.pm * BM + wr * 64 + fr, col0 = u.pn * BM + wc * 32 + 8 * fq;
#define G3A_ROW(q_, mm_) ((size_t)(row0 + ((q_) >> 1) * HALF + (((q_) & 1) * 2 + (mm_)) * 16))
#define G3A_LDS(S_, q_) do { _Pragma("unroll") for (int mm = 0; mm < 2; ++mm) _Pragma("unroll") for (int bj = 0; bj < 2; ++bj) S_[mm][bj] = *(const u32x4*)(GM + G3A_ROW(q_, mm) * 3072 + 2048 + col0 + bj * HALF); } while (0)
#define G3A_ST(S_, q_) do { _Pragma("unroll") for (int mm = 0; mm < 2; ++mm) _Pragma("unroll") for (int bj = 0; bj < 2; ++bj) { const u32x4 sg = S_[mm][bj]; \
            const f32x4 v0 = acc[(q_) >> 1][bj][((q_) & 1) * 2 + mm][0], v1 = acc[(q_) >> 1][bj][((q_) & 1) * 2 + mm][1]; u32x4 w; \
            w.x = cvt_pk_bf16(v0[0] * bflo(sg.x), v0[1] * bfhi(sg.x)); w.y = cvt_pk_bf16(v0[2] * bflo(sg.y), v0[3] * bfhi(sg.y)); \
            w.z = cvt_pk_bf16(v1[0] * bflo(sg.z), v1[1] * bfhi(sg.z)); w.w = cvt_pk_bf16(v1[2] * bflo(sg.w), v1[3] * bfhi(sg.w)); \
            *(u32x4*)(MG + G3A_ROW(q_, mm) * 1024 + col0 + bj * HALF) = w; } } while (0)
        u32x4 s0[2][2], s1[2][2];
        G3A_LDS(s0, 0); G3A_LDS(s1, 1); asm volatile("" ::: "memory");
        G3A_ST(s0, 0); G3A_LDS(s0, 2); asm volatile("" ::: "memory");
        G3A_ST(s1, 1); G3A_LDS(s1, 3); asm volatile("" ::: "memory");
        G3A_ST(s0, 2); G3A_ST(s1, 3); asm volatile("" ::: "memory");
#undef G3A_ROW
#undef G3A_LDS
#undef G3A_ST
    }
};
struct EpiG3b {
    static constexpr bool PERM = false, AFTER_DRAIN = false;
    const float* xin; float* xout;
    __device__ __forceinline__ void operator()(const f32x4 (&acc)[2][2][4][2], const Unit& u, int wr, int wc, int fr, int fq) const {
        const int row0 = u.pm * BM + wr * 64 + fr, col0 = u.pn * BM + wc * 32 + 4 * fq;
#define G3B_OFF(q_, mm_, bj_, n_) ((size_t)(row0 + ((q_) >> 1) * HALF + (((q_) & 1) * 2 + (mm_)) * 16) * 1024 + col0 + (bj_) * HALF + (n_) * 16)
#define G3B_LD(dst, q_) do { _Pragma("unroll") for (int mm = 0; mm < 2; ++mm) _Pragma("unroll") for (int bj = 0; bj < 2; ++bj) _Pragma("unroll") for (int n = 0; n < 2; ++n) dst[mm][bj][n] = *(const f32x4*)(xin + G3B_OFF(q_, mm, bj, n)); } while (0)
#define G3B_ST(src, q_) do { _Pragma("unroll") for (int mm = 0; mm < 2; ++mm) _Pragma("unroll") for (int bj = 0; bj < 2; ++bj) _Pragma("unroll") for (int n = 0; n < 2; ++n) \
            *(f32x4*)(xout + G3B_OFF(q_, mm, bj, n)) = src[mm][bj][n] + acc[(q_) >> 1][bj][((q_) & 1) * 2 + mm][n]; } while (0)
        f32x4 xa[2][2][2], xb[2][2][2];
        G3B_LD(xa, 0); G3B_LD(xb, 1); asm volatile("" ::: "memory");
        G3B_ST(xa, 0); G3B_LD(xa, 2); asm volatile("" ::: "memory");
        G3B_ST(xb, 1); G3B_LD(xb, 3); asm volatile("" ::: "memory");
        G3B_ST(xa, 2); G3B_ST(xb, 3); asm volatile("" ::: "memory");
#undef G3B_OFF
#undef G3B_LD
#undef G3B_ST
    }
};

template <class Epi, class Sched, bool ALIGN_EPI = false, bool SP2 = false, bool HOOK = false>
__device__ __forceinline__ void gemm_phase(PG8_LAS unsigned char* lds, const Gemm g, const Sched& S, const Epi& E) {
    int tid_ = threadIdx.x; asm volatile("" : "+v"(tid_));
    const int tid = tid_, wid = __builtin_amdgcn_readfirstlane(tid >> 6), lane = tid & 63, wr = wid >> 2, wc = wid & 3, fr = lane & 15, fq = lane >> 4;
    const int K = g.K, nt = K / BK;
    unsigned voffA[2], voffB[2];
#pragma unroll
    for (int i = 0; i < 2; ++i) { int R, C; stage_rc(tid * 16 + i * 8192, R, C); const int Rb = Epi::PERM ? ((R & ~31) + perm32(R & 31)) : R;
        voffA[i] = (unsigned)(R * K + C) * 2u; voffB[i] = (unsigned)(Rb * K + C) * 2u; }
    const size_t kstep = (size_t)(BK * 2);
    const size_t hstep = (size_t)HALF * K * 2;
    const size_t tstep = 2 * hstep;
    const unsigned ldsw = (unsigned)wid * 1024u;
    const int aoff = lds_byte(wr * 64 + fr, fq * 8), boff = lds_byte(wc * 32 + fr, fq * 8);
#define PG8_SA(b, h) (((b) * 2 + (h)) * HTB)
#define PG8_SB(b, h) ((4 + (b) * 2 + (h)) * HTB)
#define PG8_STAGE(bufoff, gbase, voff) do { _Pragma("unroll") for (int _i = 0; _i < 2; ++_i) \
        __builtin_amdgcn_global_load_lds((const unsigned*)((const char*)(gbase) + (voff)[_i]), (PG8_LAS unsigned*)(lds + (bufoff) + ldsw + _i * 8192), 16, 0, 0); } while (0)
#define PG8_LDA(dst, b, h) do { _Pragma("unroll") for (int m = 0; m < 4; ++m) _Pragma("unroll") for (int k = 0; k < 2; ++k) dst[m][k] = *(const PG8_LAS bf16x8*)(lds + PG8_SA(b, h) + aoff + m * 2048 + k * 1024); } while (0)
#define PG8_LDB(dst, b, h) do { _Pragma("unroll") for (int n = 0; n < 2; ++n) _Pragma("unroll") for (int k = 0; k < 2; ++k) dst[n][k] = *(const PG8_LAS bf16x8*)(lds + PG8_SB(b, h) + boff + n * 2048 + k * 1024); } while (0)
#define PG8_MMA(ai, bj, At, Bt) do { __builtin_amdgcn_s_setprio(1); _Pragma("unroll") for (int m = 0; m < 4; ++m) _Pragma("unroll") for (int n = 0; n < 2; ++n) _Pragma("unroll") for (int k = 0; k < 2; ++k) \
        acc[ai][bj][m][n] = __builtin_amdgcn_mfma_f32_16x16x32_bf16(Bt[n][k], At[m][k], acc[ai][bj][m][n], 0, 0, 0); __builtin_amdgcn_s_setprio(0); } while (0)
#define PG8_WAIT_V(n) asm volatile("s_waitcnt vmcnt(" #n ")" ::: "memory")
#define PG8_WAIT_L(n) asm volatile("s_waitcnt lgkmcnt(" #n ")" ::: "memory")
#define PG8_BAR __builtin_amdgcn_s_barrier()
#define PG8_SCHED __builtin_amdgcn_sched_barrier(0)
    Unit cur, nxt; int ui = 0;
    if (!S.next(0, cur)) return;
    f32x4 acc[2][2][4][2];
#pragma unroll
    for (int a = 0; a < 2; ++a)
#pragma unroll
        for (int b = 0; b < 2; ++b)
#pragma unroll
            for (int m = 0; m < 4; ++m)
#pragma unroll
                for (int n = 0; n < 2; ++n) acc[a][b][m][n] = (f32x4){0.f, 0.f, 0.f, 0.f};
    bf16x8 At[4][2], B0[2][2], B1[2][2];
    const char* cA = (const char*)g.A + (size_t)cur.pm * tstep; const char* cB = (const char*)g.Bt + (size_t)cur.pn * tstep;
    S.a_ready(cur);
    if constexpr (SP2) {
        PG8_STAGE(PG8_SB(0, 0), cB, voffB); PG8_STAGE(PG8_SB(0, 1), cB + hstep, voffB); PG8_STAGE(PG8_SA(0, 0), cA, voffA); PG8_STAGE(PG8_SA(0, 1), cA + hstep, voffA);
        if (wr == 1) PG8_BAR;
        PG8_WAIT_V(2); PG8_BAR;
        PG8_STAGE(PG8_SB(1, 0), cB + kstep, voffB); PG8_STAGE(PG8_SA(1, 0), cA + kstep, voffA); PG8_STAGE(PG8_SB(1, 1), cB + hstep + kstep, voffB);
        PG8_WAIT_V(6); PG8_BAR;
    } else {
        PG8_STAGE(PG8_SB(0, 0), cB, voffB); PG8_STAGE(PG8_SA(0, 0), cA, voffA); PG8_STAGE(PG8_SB(0, 1), cB + hstep, voffB); PG8_STAGE(PG8_SA(0, 1), cA + hstep, voffA);
        if (wr == 1) PG8_BAR;
        PG8_WAIT_V(4); PG8_BAR;
        PG8_STAGE(PG8_SB(1, 0), cB + kstep, voffB); PG8_STAGE(PG8_SA(1, 0), cA + kstep, voffA); PG8_STAGE(PG8_SB(1, 1), cB + hstep + kstep, voffB);
        PG8_WAIT_V(6); PG8_BAR;
    }
    for (;;) {
        const bool has_next = S.next(ui + 1, nxt);
        const char* nA = has_next ? (const char*)g.A + (size_t)nxt.pm * tstep : cA; const char* nB = has_next ? (const char*)g.Bt + (size_t)nxt.pn * tstep : cB;
        for (int t = 0; t < nt; t += 2) {
            if constexpr (HOOK) { if (t == 8 || t == 16) E.mid(acc, cur, t >> 4, wr, wc, fr, fq); }
            const bool last = (t == nt - 2);
            const char* a1 = cA + (size_t)(t + 1) * kstep;
            const char* a2 = last ? nA : cA + (size_t)(t + 2) * kstep; const char* b2 = last ? nB : cB + (size_t)(t + 2) * kstep;
            const char* a3 = a2 + kstep; const char* b3 = b2 + kstep;
            if (last && has_next) S.a_ready(nxt);
            if constexpr (SP2) {
            PG8_LDB(B0, 0, 0); PG8_LDB(B1, 0, 1); PG8_SCHED; PG8_LDA(At, 0, 0); PG8_STAGE(PG8_SA(1, 1), a1 + hstep, voffA);
            PG8_WAIT_V(8); PG8_WAIT_L(0); PG8_BAR; PG8_MMA(0, 0, At, B0); PG8_MMA(0, 1, At, B1); PG8_BAR; PG8_SCHED;
            PG8_LDA(At, 0, 1); PG8_STAGE(PG8_SB(0, 0), b2, voffB); PG8_STAGE(PG8_SB(0, 1), b2 + hstep, voffB); PG8_STAGE(PG8_SA(0, 0), a2, voffA);
            PG8_WAIT_V(8); PG8_WAIT_L(0); PG8_BAR; PG8_MMA(1, 0, At, B0); PG8_MMA(1, 1, At, B1); PG8_BAR; PG8_SCHED;
            PG8_LDB(B0, 1, 0); PG8_LDB(B1, 1, 1); PG8_SCHED; PG8_LDA(At, 1, 0); PG8_STAGE(PG8_SA(0, 1), a2 + hstep, voffA);
            PG8_WAIT_V(8); PG8_WAIT_L(0); PG8_BAR; PG8_MMA(0, 0, At, B0); PG8_MMA(0, 1, At, B1); PG8_BAR; PG8_SCHED;
            PG8_LDA(At, 1, 1); PG8_STAGE(PG8_SB(1, 0), b3, voffB); PG8_STAGE(PG8_SB(1, 1), b3 + hstep, voffB); PG8_STAGE(PG8_SA(1, 0), a3, voffA);
            PG8_WAIT_V(8); PG8_WAIT_L(0); PG8_BAR; PG8_MMA(1, 0, At, B0); PG8_MMA(1, 1, At, B1); PG8_BAR; PG8_SCHED;
            } else {
            PG8_LDB(B0, 0, 0); PG8_SCHED; PG8_LDA(At, 0, 0); PG8_STAGE(PG8_SA(1, 1), a1 + hstep, voffA);
            PG8_WAIT_L(8); PG8_BAR; PG8_WAIT_L(0); PG8_MMA(0, 0, At, B0); PG8_BAR; PG8_SCHED;
            PG8_LDB(B1, 0, 1); PG8_STAGE(PG8_SB(0, 0), b2, voffB);
            PG8_BAR; PG8_WAIT_L(0); PG8_MMA(0, 1, At, B1); PG8_BAR;
            PG8_LDA(At, 0, 1); PG8_STAGE(PG8_SA(0, 0), a2, voffA);
            PG8_BAR; PG8_WAIT_L(0); PG8_MMA(1, 0, At, B0); PG8_BAR; PG8_SCHED;
            PG8_STAGE(PG8_SB(0, 1), b2 + hstep, voffB);
            PG8_WAIT_V(6); PG8_BAR; PG8_MMA(1, 1, At, B1); PG8_BAR;
            PG8_LDB(B0, 1, 0); PG8_SCHED; PG8_LDA(At, 1, 0); PG8_STAGE(PG8_SA(0, 1), a2 + hstep, voffA);
            PG8_WAIT_L(8); PG8_BAR; PG8_WAIT_L(0); PG8_MMA(0, 0, At, B0); PG8_BAR; PG8_SCHED;
            PG8_LDB(B1, 1, 1); PG8_STAGE(PG8_SB(1, 0), b3, voffB);
            PG8_BAR; PG8_WAIT_L(0); PG8_MMA(0, 1, At, B1); PG8_BAR;
            PG8_LDA(At, 1, 1); PG8_STAGE(PG8_SA(1, 0), a3, voffA);
            PG8_BAR; PG8_WAIT_L(0); PG8_MMA(1, 0, At, B0); PG8_BAR; PG8_SCHED;
            PG8_STAGE(PG8_SB(1, 1), b3 + hstep, voffB);
            PG8_WAIT_V(6); PG8_BAR; PG8_MMA(1, 1, At, B1); PG8_BAR;
            }
        }
        if constexpr (ALIGN_EPI) { if (wr == 0) PG8_BAR; }
        if constexpr (!Epi::AFTER_DRAIN) { E(acc, cur, wr, wc, fr, fq); S.done(cur); }
        if (!has_next) break;
#pragma unroll
        for (int a = 0; a < 2; ++a)
#pragma unroll
            for (int b = 0; b < 2; ++b)
#pragma unroll
                for (int m = 0; m < 4; ++m)
#pragma unroll
                    for (int n = 0; n < 2; ++n) acc[a][b][m][n] = (f32x4){0.f, 0.f, 0.f, 0.f};
        cur = nxt; cA = nA; cB = nB; ++ui;
        if constexpr (ALIGN_EPI) { if (wr == 1) PG8_BAR; }
    }
    PG8_WAIT_V(0);
    if constexpr (!ALIGN_EPI) { if (wr == 0) PG8_BAR; }
    PG8_BAR;
    if constexpr (Epi::AFTER_DRAIN) { E.fused(acc, cur, wr, wc, fr, fq, lds, wid, lane); S.done(cur); }
#undef PG8_SA
#undef PG8_SB
#undef PG8_STAGE
#undef PG8_LDA
#undef PG8_LDB
#undef PG8_MMA
#undef PG8_WAIT_V
#undef PG8_WAIT_L
#undef PG8_BAR
#undef PG8_SCHED
}
}
#define LAS __attribute__((address_space(3)))
typedef unsigned short bf16;
typedef short bf16x8 __attribute__((ext_vector_type(8)));
typedef float f32x4 __attribute__((ext_vector_type(4)));
typedef float f32x16 __attribute__((ext_vector_type(16)));
typedef unsigned u32x4 __attribute__((ext_vector_type(4)));
typedef unsigned u32x2 __attribute__((ext_vector_type(2)));

constexpr int M = 32768, D = 1024, SEQ = 4096, DIN = 8456, NW1 = 8704, DEPTH = 4;
constexpr int N1A = 2816, N1V = 1280, N1B = 4608;
constexpr float LOG2E = 1.4426950408889634f, QSCALE = 0.125f * 1.4426950408889634f;
constexpr size_t MiB = 1u << 20;
constexpr size_t WS_LOGF = 1 * MiB, WS_W1 = 2 * MiB, WS_WUP = 70 * MiB, WS_WO = 82 * MiB, WS_XB = 90 * MiB, WS_Y = 154 * MiB, WS_QK = 250 * MiB, WS_VT = 426 * MiB, WS_GM = 250 * MiB, WS_END = 506 * MiB;
constexpr int LDS_BYTES = 147456;
constexpr int NPHASE = 1 + 6 * DEPTH;
#ifndef ENMASK
#define ENMASK 0xff
#endif
#define EN(k) (((ENMASK) >> (k)) & 1)
#ifndef MK_N_LAUNCHES
#define MK_N_LAUNCHES 1
#endif

__device__ __forceinline__ float wave_sum(float v) {
#pragma unroll
    for (int o = 1; o < 64; o <<= 1) v += __shfl_xor(v, o);
    return v;
}
__device__ __forceinline__ float xhalf_max(float v) { auto rr = __builtin_amdgcn_permlane32_swap(__float_as_uint(v), __float_as_uint(v), false, false); return fmaxf(__uint_as_float(rr[0]), __uint_as_float(rr[1])); }
__device__ __forceinline__ float xhalf_sum(float v) { auto rr = __builtin_amdgcn_permlane32_swap(__float_as_uint(v), __float_as_uint(v), false, false); return __uint_as_float(rr[0]) + __uint_as_float(rr[1]); }
__device__ __forceinline__ unsigned pk2(float lo, float hi) { return pg8::cvt_pk_bf16(lo, hi); }
__device__ __forceinline__ int crow(int r, int hi) { return (r & 3) + 8 * (r >> 2) + 4 * hi; }

__device__ __forceinline__ void transpose_item(const float* __restrict__ src, int src_pitch, int src_col0, int k0, bf16* __restrict__ dst, int dst_pitch, int dst_row0, int dst_col0,
                                               float scale, const float* __restrict__ gain, bool zero, LAS float* scr, int lane) {
#pragma unroll
    for (int i = 0; i < 8; ++i) { const int kk = 8 * i + (lane >> 3), n4 = 4 * (lane & 7);
        f32x4 v = {0.f, 0.f, 0.f, 0.f};
        if (!zero) { v = *(const f32x4*)(src + (size_t)(k0 + kk) * src_pitch + src_col0 + n4); float g = scale; if (gain) g *= gain[k0 + kk]; v = v * g; }
        scr[kk * 33 + n4] = v[0]; scr[kk * 33 + n4 + 1] = v[1]; scr[kk * 33 + n4 + 2] = v[2]; scr[kk * 33 + n4 + 3] = v[3]; }
    asm volatile("s_waitcnt lgkmcnt(0)" ::: "memory");
    const int c = lane & 7;
#pragma unroll
    for (int j = 0; j < 4; ++j) { const int n = (lane >> 3) + 8 * j; const LAS float* s = scr + (8 * c) * 33 + n;
        u32x4 o; o.x = pk2(s[0 * 33], s[1 * 33]); o.y = pk2(s[2 * 33], s[3 * 33]); o.z = pk2(s[4 * 33], s[5 * 33]); o.w = pk2(s[6 * 33], s[7 * 33]);
        *(u32x4*)(dst + (size_t)(dst_row0 + n) * dst_pitch + dst_col0 + k0 + 8 * c) = o; }
    asm volatile("s_waitcnt lgkmcnt(0)" ::: "memory");
}
__device__ __forceinline__ bool w1_map(int r, int& src, float& scale) {
    scale = 1.f;
    if (r < 512) { src = r; scale = QSCALE; return true; }
    if (r < 1024) { src = 512 + (r - 512); return true; }
    if (r < 1536) { src = 2048 + (r - 1024); scale = QSCALE; return true; }
    if (r < 2048) { src = 3328 + (r - 1536); scale = QSCALE; return true; }
    if (r < 2560) { src = 3840 + (r - 2048); return true; }
    if (r < 2688) { src = 2560 + (r - 2560); return true; }
    if (r < 2816) { src = 0; return false; }
    if (r < 3328) { src = 1024 + (r - 2816); return true; }
    if (r < 3840) { src = 4352 + (r - 3328); return true; }
    if (r < 3968) { src = 2688 + (r - 3840); return true; }
    if (r < 4096) { src = 0; return false; }
    if (r < 4608) { src = 1536 + (r - 4096); return true; }
    if (r < 5120) { src = 2816 + (r - 4608); return true; }
    if (r < 5632) { src = 4872 + (r - 5120); return true; }
    src = 5384 + (r - 5632); return true;
}

#define XB_TMO      128
#define XB_XCNT(j)  (256  + 64 * (j))
#define XB_XSUB(j)  (1280 + 64 * (j))
#define XB_XGEN(j)  (2304 + 64 * (j))
#define XB_TOP      3328
#define XB_TOPGEN   3392
#define XCD_BAR_WORDS 3456
#define XB_SPIN_CAP (1u << 18)

__device__ __forceinline__ unsigned xb_ld(unsigned* p)              { return __hip_atomic_load(p, __ATOMIC_RELAXED, __HIP_MEMORY_SCOPE_AGENT); }
__device__ __forceinline__ unsigned xb_add(unsigned* p, unsigned v) { return __hip_atomic_fetch_add(p, v, __ATOMIC_RELAXED, __HIP_MEMORY_SCOPE_AGENT); }
__device__ __forceinline__ unsigned xb_xcc_id() { return (unsigned)__builtin_amdgcn_s_getreg((3 << 11) | 20) & 0xFu; }
#define XB_SPIN(cond, bar) do { unsigned _sp = 0; while (cond) { __builtin_amdgcn_s_sleep(1); \
    if ((++_sp & 255u) == 0u) { if (xb_ld(&(bar)[XB_TMO])) break; if (_sp > XB_SPIN_CAP) { atomicAdd(&(bar)[XB_TMO], 1u); break; } } } } while (0)

struct XcdBarrier {
    unsigned* bar; unsigned x;
    volatile LAS unsigned* st;
};

__device__ __forceinline__ XcdBarrier xcd_barrier_post(unsigned* bar, volatile LAS unsigned* st) {
    XcdBarrier b; b.bar = bar; b.x = xb_xcc_id(); b.st = st;
    if (threadIdx.x == 0) (void)xb_add(&bar[XB_XCNT(b.x)], 1u);
    return b;
}
__device__ __forceinline__ void xcd_barrier_complete(unsigned* bar, unsigned x, unsigned& nloc, unsigned& nx) {
    const unsigned G = gridDim.x * gridDim.y * gridDim.z;
    unsigned sum, cnt, mine, sp = 0u;
    for (;;) {
        sum = 0u; cnt = 0u; mine = 0u;
#pragma unroll
        for (unsigned j = 0; j < 16; ++j) { const unsigned c = xb_ld(&bar[XB_XCNT(j)]); sum += c; cnt += (c > 0u) ? 1u : 0u; mine = (j == x) ? c : mine; }
        if (sum == G) break;
        __builtin_amdgcn_s_sleep(1);
        if ((++sp & 255u) == 0u) { if (xb_ld(&bar[XB_TMO])) break; if (sp > XB_SPIN_CAP) { atomicAdd(&bar[XB_TMO], 1u); break; } }
    }
    nloc = mine > 0u ? mine : 1u; nx = cnt > 0u ? cnt : 1u;
}

__device__ __forceinline__ void xcd_barrier(const XcdBarrier& b) {
    asm volatile("s_waitcnt vmcnt(0)" ::: "memory");
    __syncthreads();
    if (threadIdx.x == 0) {
        unsigned* bar = b.bar;
        __builtin_amdgcn_s_waitcnt(0);
        unsigned nloc = b.st[0], nx = b.st[1];
        if (nloc == 0u) { xcd_barrier_complete(bar, b.x, nloc, nx); b.st[0] = nloc; b.st[1] = nx; }
        const unsigned old = xb_add(&bar[XB_XSUB(b.x)], 1u);
        const unsigned gen = old / nloc;
        if (old + 1u == (gen + 1u) * nloc) {
            __builtin_amdgcn_fence(__ATOMIC_RELEASE, "agent");
            asm volatile("s_waitcnt vmcnt(0)" ::: "memory");
            const unsigned og = xb_add(&bar[XB_TOP], 1u);
            const unsigned tg = og / nx;
            if (og + 1u == (tg + 1u) * nx) xb_add(&bar[XB_TOPGEN], 1u);
            else XB_SPIN(xb_ld(&bar[XB_TOPGEN]) == tg, bar);
            __builtin_amdgcn_fence(__ATOMIC_ACQUIRE, "agent");
            xb_add(&bar[XB_XGEN(b.x)], 1u);
            asm volatile("s_waitcnt vmcnt(0)" ::: "memory");
        } else {
            XB_SPIN(xb_ld(&bar[XB_XGEN(b.x)]) == gen, bar);
            __builtin_amdgcn_fence(__ATOMIC_ACQUIRE, "agent");
            asm volatile("s_waitcnt vmcnt(0)" ::: "memory");
        }
    }
    __syncthreads();
}

constexpr size_t WS_BAR = 65536;
struct Args { const float* in[15]; float* out; unsigned char* ws; int ph_lo, ph_hi; };

__device__ __forceinline__ void norm_pass(LAS unsigned char* lds, const Args& a, const float* xsrc, int layer, int gw, int ngw) {
    int tid_ = threadIdx.x; asm volatile("" : "+v"(tid_));
    const int tid = tid_, lane = tid & 63;
    LAS float* Wt = (LAS float*)lds;
    const float* wsrc = a.in[2] + (size_t)layer * D * DIN + 4864; const float* gain = a.in[1] + layer * D;
    for (int d = tid; d < D; d += 512) { const f32x4 w0 = *(const f32x4*)(wsrc + (size_t)d * DIN), w1 = *(const f32x4*)(wsrc + (size_t)d * DIN + 4); const float g = gain[d];
        Wt[0 * D + d] = w0[0] * g; Wt[1 * D + d] = w0[1] * g; Wt[2 * D + d] = w0[2] * g; Wt[3 * D + d] = w0[3] * g;
        Wt[4 * D + d] = w1[0] * g; Wt[5 * D + d] = w1[1] * g; Wt[6 * D + d] = w1[2] * g; Wt[7 * D + d] = w1[3] * g; }
    __syncthreads();
    bf16* XB = (bf16*)(a.ws + WS_XB); float* logf = (float*)(a.ws + WS_LOGF);
    if (gw * 64 + lane < 128 * 11) ((float*)a.ws)[gw * 64 + lane] = 0.f;
    if (gw == 0 && lane < 24) ((unsigned*)(a.ws + 32768))[64 * lane] = 0u;
    const float bj = a.in[3][layer * 8 + (lane & 7)];
    f32x4 vn[4];
    if (gw < M) { const f32x4* xr = (const f32x4*)(xsrc + (size_t)gw * D) + lane;
#pragma unroll
        for (int j = 0; j < 4; ++j) vn[j] = xr[64 * j]; }
    for (int row = gw; row < M; row += ngw) {
        f32x4 v[4]; float ss = 0.f;
#pragma unroll
        for (int j = 0; j < 4; ++j) { v[j] = vn[j]; ss += (v[j][0] * v[j][0] + v[j][1] * v[j][1]) + (v[j][2] * v[j][2] + v[j][3] * v[j][3]); }
        if (row + ngw < M) { const f32x4* xr = (const f32x4*)(xsrc + (size_t)(row + ngw) * D) + lane;
#pragma unroll
            for (int j = 0; j < 4; ++j) vn[j] = xr[64 * j]; }
        const float r = 1.0f / sqrtf(wave_sum(ss) * (1.f / D) + 1e-6f);
        unsigned long long* o8 = (unsigned long long*)(XB + (size_t)row * D) + lane;
#pragma unroll
        for (int j = 0; j < 4; ++j) o8[64 * j] = (unsigned long long)pk2(v[j][0] * r, v[j][1] * r) | ((unsigned long long)pk2(v[j][2] * r, v[j][3] * r) << 32);
        float fc[8];
#pragma unroll
        for (int jj = 0; jj < 8; ++jj) { float s = 0.f;
#pragma unroll
            for (int j = 0; j < 4; ++j) { const f32x4 w = *(const LAS f32x4*)(Wt + jj * D + 256 * j + 4 * lane); s += (v[j][0] * w[0] + v[j][1] * w[1]) + (v[j][2] * w[2] + v[j][3] * w[3]); }
            fc[jj] = wave_sum(s); }
        const int js = lane & 7;
        float f = js == 0 ? fc[0] : js == 1 ? fc[1] : js == 2 ? fc[2] : js == 3 ? fc[3] : js == 4 ? fc[4] : js == 5 ? fc[5] : js == 6 ? fc[6] : fc[7];
        f = f * r + bj;
        const float lf = fminf(f, 0.f) - log1pf(expf(-fabsf(f)));
        if (lane < 8) logf[(size_t)row * 8 + lane] = lf;
    }
    __syncthreads();
}
__device__ __forceinline__ void final_pass(const Args& a, int gw, int ngw) {
    int lane_ = threadIdx.x & 63; asm volatile("" : "+v"(lane_)); const int lane = lane_; const float* fg = a.in[14];
    f32x4 g[4];
#pragma unroll
    for (int j = 0; j < 4; ++j) g[j] = *((const f32x4*)fg + lane + 64 * j);
    f32x4 vn[4];
    if (gw < M) { const f32x4* xn = (const f32x4*)(a.out + (size_t)gw * D) + lane;
#pragma unroll
        for (int j = 0; j < 4; ++j) vn[j] = xn[64 * j]; }
    for (int row = gw; row < M; row += ngw) {
        f32x4* xr = (f32x4*)(a.out + (size_t)row * D) + lane;
        f32x4 v[4]; float ss = 0.f;
#pragma unroll
        for (int j = 0; j < 4; ++j) { v[j] = vn[j]; ss += (v[j][0] * v[j][0] + v[j][1] * v[j][1]) + (v[j][2] * v[j][2] + v[j][3] * v[j][3]); }
        if (row + ngw < M) { const f32x4* xn = (const f32x4*)(a.out + (size_t)(row + ngw) * D) + lane;
#pragma unroll
            for (int j = 0; j < 4; ++j) vn[j] = xn[64 * j]; }
        const float r = 1.0f / sqrtf(wave_sum(ss) * (1.f / D) + 1e-6f);
#pragma unroll
        for (int j = 0; j < 4; ++j) xr[64 * j] = v[j] * r * g[j];
    }
}

template <int MODE> struct AttCfg {
    static constexpr int DV = MODE == 0 ? 128 : 64, ROWS = MODE == 2 ? 256 : MODE == 1 ? 64 : 128, KROWB = MODE == 0 ? 256 : 128, KSTR = KROWB + 16, VSTR = 136, NC = DV / 32;
    static constexpr int NKL = KROWB / 128, NVL = DV / 64, KCH = KROWB / 16;
    static constexpr int KB_OFF = 0, VB_OFF = 34816, BI_OFF = MODE == 1 ? 71680 : 69632, WS_OFF = 70144, VOTE_OFF = 71168, XC_OFF = 71680;
    static constexpr bool REV = MODE != 1;
};
#define ATT_SB() __builtin_amdgcn_sched_barrier(0)
template <int MODE>
__device__ __forceinline__ void att_tile(LAS unsigned char* lds, int buf, int kv0, int wq0, int r32, int hi, int mapi, const bf16x8 (&qr)[4], f32x16 (&O)[AttCfg<MODE>::NC], float& mrun, float& lsum, LAS float* wsf, bool fixed = false  ) {
    typedef AttCfg<MODE> C; constexpr int NC = C::NC;
    const float NEG = -__builtin_inff();
    f32x16 p0, p1; bf16x8 kf[8]; u32x4 vf[2 * NC];
    const LAS unsigned char* vb = lds + C::VB_OFF + buf * C::DV * C::VSTR + r32 * C::VSTR + hi * 8;
    ATT_SB();
    { const LAS float* bp = (const LAS float*)(lds + C::BI_OFF) + (MODE == 1 ? mapi * 128 : 0) + buf * 64 + 4 * hi;
      const LAS unsigned char* kb = lds + C::KB_OFF + buf * 64 * C::KSTR + (MODE == 0 ? mapi * 128 : 0) + hi * 16 + r32 * C::KSTR;
#pragma unroll
      for (int i = 0; i < 4; ++i) { const f32x4 b0 = *(const LAS f32x4*)(bp + 8 * i), b1 = *(const LAS f32x4*)(bp + 32 + 8 * i);
#pragma unroll
          for (int k = 0; k < 4; ++k) { p0[4 * i + k] = b0[k]; p1[4 * i + k] = b1[k]; } }
#pragma unroll
      for (int d0 = 0; d0 < 4; ++d0) { kf[2 * d0] = *(const LAS bf16x8*)(kb + d0 * 32); kf[2 * d0 + 1] = *(const LAS bf16x8*)(kb + 32 * C::KSTR + d0 * 32); }
 }
    ATT_SB();
#pragma unroll
    for (int d0 = 0; d0 < 4; ++d0) { p0 = __builtin_amdgcn_mfma_f32_32x32x16_bf16(kf[2 * d0], qr[d0], p0, 0, 0, 0); p1 = __builtin_amdgcn_mfma_f32_32x32x16_bf16(kf[2 * d0 + 1], qr[d0], p1, 0, 0, 0); }
    ATT_SB();
#pragma unroll
    for (int j = 0; j < 2; ++j)
#pragma unroll
        for (int c = 0; c < NC; ++c) { const u32x2 lo = *(const LAS u32x2*)(vb + c * 32 * C::VSTR + j * 32), hh = *(const LAS u32x2*)(vb + c * 32 * C::VSTR + j * 32 + 16); vf[j * NC + c] = (u32x4){lo.x, lo.y, hh.x, hh.y}; }
    ATT_SB();
    const bool full = (kv0 + 63 <= wq0) && (MODE != 1 || (wq0 + 31 - kv0) < 128);
    if (!full) { const int qpos = wq0 + r32;
#pragma unroll
        for (int r = 0; r < 16; ++r) { const int kv = kv0 + crow(r, hi); bool ok0 = kv <= qpos, ok1 = kv + 32 <= qpos;
            if (MODE == 1) { ok0 = ok0 && (qpos - kv < 128); ok1 = ok1 && (qpos - kv - 32 < 128); }
            p0[r] = ok0 ? p0[r] : NEG; p1[r] = ok1 ? p1[r] : NEG; } }
    float msafe = mrun, alpha = 1.0f;
    if (!fixed) {
        float mxa = __builtin_fmaxf(p0[0], p0[1]), mxb = __builtin_fmaxf(p1[0], p1[1]);
#pragma unroll
        for (int r = 2; r < 16; r += 2) { mxa = __builtin_fmaxf(__builtin_fmaxf(mxa, p0[r]), p0[r + 1]); mxb = __builtin_fmaxf(__builtin_fmaxf(mxb, p1[r]), p1[r + 1]); }
        float mx = __builtin_fmaxf(mxa, mxb);
        mx = xhalf_max(mx);
        const float mnew = fmaxf(mrun, mx); msafe = (mnew == NEG) ? 0.f : mnew;
        alpha = __builtin_amdgcn_exp2f(mrun - msafe); mrun = mnew;
    }
    float ps = 0.f;
#pragma unroll
    for (int r = 0; r < 16; ++r) { p0[r] = __builtin_amdgcn_exp2f(p0[r] - msafe); p1[r] = __builtin_amdgcn_exp2f(p1[r] - msafe); ps += p0[r] + p1[r]; }
    lsum = lsum * alpha + ps;
    if (!fixed) {
    if (__any(alpha != 1.0f)) {
        if (hi == 0) wsf[r32] = alpha;
        asm volatile("s_waitcnt lgkmcnt(0)" ::: "memory");
#pragma unroll
        for (int i = 0; i < 4; ++i) { const f32x4 av = *(const LAS f32x4*)(wsf + 8 * i + 4 * hi);
#pragma unroll
            for (int c = 0; c < NC; ++c)
#pragma unroll
                for (int k = 0; k < 4; ++k) O[c][4 * i + k] *= av[k]; }
        asm volatile("s_waitcnt lgkmcnt(0)" ::: "memory");
    }
    }
    bf16x8 pa[4];
    { u32x4 w;
      w.x = pk2(p0[0], p0[1]); w.y = pk2(p0[2], p0[3]); w.z = pk2(p0[4], p0[5]); w.w = pk2(p0[6], p0[7]); pa[0] = __builtin_bit_cast(bf16x8, w);
      w.x = pk2(p0[8], p0[9]); w.y = pk2(p0[10], p0[11]); w.z = pk2(p0[12], p0[13]); w.w = pk2(p0[14], p0[15]); pa[1] = __builtin_bit_cast(bf16x8, w);
      w.x = pk2(p1[0], p1[1]); w.y = pk2(p1[2], p1[3]); w.z = pk2(p1[4], p1[5]); w.w = pk2(p1[6], p1[7]); pa[2] = __builtin_bit_cast(bf16x8, w);
      w.x = pk2(p1[8], p1[9]); w.y = pk2(p1[10], p1[11]); w.z = pk2(p1[12], p1[13]); w.w = pk2(p1[14], p1[15]); pa[3] = __builtin_bit_cast(bf16x8, w); }
    ATT_SB();
    u32x4 vg[2 * NC];
#pragma unroll
    for (int j = 0; j < 2; ++j)
#pragma unroll
        for (int c = 0; c < NC; ++c) { const u32x2 lo = *(const LAS u32x2*)(vb + c * 32 * C::VSTR + (j + 2) * 32), hh = *(const LAS u32x2*)(vb + c * 32 * C::VSTR + (j + 2) * 32 + 16); vg[j * NC + c] = (u32x4){lo.x, lo.y, hh.x, hh.y}; }
    ATT_SB();
#pragma unroll
    for (int j = 0; j < 2; ++j)
#pragma unroll
        for (int c = 0; c < NC; ++c) O[c] = __builtin_amdgcn_mfma_f32_32x32x16_bf16(pa[j], __builtin_bit_cast(bf16x8, vf[j * NC + c]), O[c], 0, 0, 0);
    ATT_SB();
#pragma unroll
    for (int j = 0; j < 2; ++j)
#pragma unroll
        for (int c = 0; c < NC; ++c) O[c] = __builtin_amdgcn_mfma_f32_32x32x16_bf16(pa[j + 2], __builtin_bit_cast(bf16x8, vg[j * NC + c]), O[c], 0, 0, 0);
    ATT_SB();
}

template <int MODE>
__device__ __forceinline__ void attn_unit(LAS unsigned char* lds, const bf16* __restrict__ QK, const bf16* __restrict__ VT, bf16* __restrict__ Y, const float* __restrict__ logf,
                                          int b, int h, int qblk, float sl2, float sink2, float lam, float subfac, const float* __restrict__ subg, float kinf) {
    typedef AttCfg<MODE> C;
    constexpr int DV = C::DV, ROWS = C::ROWS, KSTR = C::KSTR, VSTR = C::VSTR, NC = C::NC, NKL = C::NKL, NVL = C::NVL, KCH = C::KCH;
    constexpr int KB_OFF = C::KB_OFF, VB_OFF = C::VB_OFF, BI_OFF = C::BI_OFF, WS_OFF = C::WS_OFF, VOTE_OFF = C::VOTE_OFF, XC_OFF = C::XC_OFF;
    constexpr bool REV = C::REV;
    const float NEG = -__builtin_inff();
    int tid_ = threadIdx.x; asm volatile("" : "+v"(tid_));
    const int tid = tid_, lane = tid & 63, wid = __builtin_amdgcn_readfirstlane(tid >> 6), r32 = lane & 31, hi = lane >> 5;
    const int q0 = qblk * ROWS, wq0 = q0 + 32 * (MODE == 2 ? wid : MODE == 1 ? (wid & 1) : (wid & 3)), mapi = MODE == 2 ? 0 : MODE == 1 ? (wid >> 1) : (wid >> 2), heff = MODE == 1 ? h + mapi : h;
    const float sl2w = MODE == 1 ? sl2 * (1.0f / (float)(1 << mapi)) : sl2, sink2w = MODE == 1 ? subg[heff] * LOG2E : sink2;
    const size_t tok0 = (size_t)b * SEQ;
    const int qcol = MODE == 0 ? h * 128 + mapi * 64 : MODE == 1 ? 1024 + heff * 64 : 1536 + h * 64;
    const int kcol = MODE == 0 ? 512 + h * 128 : MODE == 1 ? 2560 + (h >> 2) * 64 : 2048 + h * 64;
    const int vrow = MODE == 0 ? h * 128 : MODE == 1 ? 1024 + (h >> 2) * 64 : 512 + h * 64;
    const int ycol = MODE == 0 ? h * 128 : MODE == 1 ? 512 + heff * 64 : 1024 + h * 64;
    const bf16* Kg = QK + tok0 * N1A + kcol;
    const bf16* Vg = VT + (size_t)vrow * M + tok0;
    bf16x8 qr[4];
    { const bf16* qp = QK + (tok0 + wq0 + r32) * N1A + qcol + hi * 8;
#pragma unroll
      for (int d0 = 0; d0 < 4; ++d0) qr[d0] = *(const bf16x8*)(qp + d0 * 16); }
    float qkb = 0.f;
    if (REV) {
#pragma unroll
        for (int d0 = 0; d0 < 4; ++d0) { const u32x4 w = __builtin_bit_cast(u32x4, qr[d0]);
            qkb += fabsf(pg8::bflo(w.x)) + fabsf(pg8::bfhi(w.x)) + fabsf(pg8::bflo(w.y)) + fabsf(pg8::bfhi(w.y)) + fabsf(pg8::bflo(w.z)) + fabsf(pg8::bfhi(w.z)) + fabsf(pg8::bflo(w.w)) + fabsf(pg8::bfhi(w.w)); }
        qkb = xhalf_sum(qkb) * kinf * 1.02f;
    }
    const int t_lo = MODE == 1 ? (q0 >= 128 ? (q0 - 128) / 64 : 0) : 0, t_hi = (q0 + ROWS) / 64;
    int kgoff[NKL], kloff[NKL], vgoff[NVL], vloff[NVL];
#pragma unroll
    for (int i = 0; i < NKL; ++i) { const int idx = tid + 512 * i, row = idx / KCH, ch = idx % KCH; kgoff[i] = row * N1A + ch * 8; kloff[i] = row * KSTR + ch * 16; }
#pragma unroll
    for (int i = 0; i < NVL; ++i) { const int idx = tid + 512 * i, row = idx >> 3, ch = idx & 7; vgoff[i] = row * M + ch * 8; vloff[i] = row * VSTR + ch * 16; }
    u32x4 kstA[NKL], vstA[NVL], kstB[NKL], vstB[NVL]; float lfA = 0.f, lfB = 0.f, carry = 0.f;
#define ATT_LOAD(t, KS, VS, LF) do { const char* kb_ = (const char*)Kg + (size_t)(t) * (64 * N1A * 2); const char* vb_ = (const char*)Vg + (size_t)(t) * 128; \
        _Pragma("unroll") for (int i_ = 0; i_ < NKL; ++i_) KS[i_] = *(const u32x4*)(kb_ + (unsigned)(2 * kgoff[i_])); \
        _Pragma("unroll") for (int i_ = 0; i_ < NVL; ++i_) VS[i_] = *(const u32x4*)(vb_ + (unsigned)(2 * vgoff[i_])); \
        if (MODE == 2 && wid == 0) LF = logf[(tok0 + (t) * 64 + lane) * 8 + h]; } while (0)
#define ATT_WRITE(t, bufi, KS, VS, LF) do { _Pragma("unroll") for (int i_ = 0; i_ < NKL; ++i_) *(LAS u32x4*)(lds + KB_OFF + (bufi) * 64 * KSTR + kloff[i_]) = KS[i_]; \
        _Pragma("unroll") for (int i_ = 0; i_ < NVL; ++i_) { LAS unsigned char* vp_ = lds + VB_OFF + (bufi) * DV * VSTR + vloff[i_]; *(LAS u32x2*)vp_ = (u32x2){VS[i_].x, VS[i_].y}; *(LAS u32x2*)(vp_ + 8) = (u32x2){VS[i_].z, VS[i_].w}; } \
        if ((MODE == 1 ? (wid & 1) : wid) == 0) { float bv_; if (MODE == 2) { float v_ = LF; _Pragma("unroll") for (int o_ = 1; o_ < 64; o_ <<= 1) { const float u_ = __shfl_down(v_, o_); if (lane + o_ < 64) v_ += u_; } \
                bv_ = (carry + v_ - LF) * LOG2E; carry += __shfl(v_, 0); } else bv_ = sl2w * (float)((t) * 64 + lane - q0); \
            ((LAS float*)(lds + BI_OFF))[(MODE == 1 ? mapi * 128 : 0) + (bufi) * 64 + lane] = bv_; } } while (0)
    float mrun = NEG, lsum = 0.f;
    if (MODE == 1) { mrun = sink2w + sl2w * (float)(wq0 + r32 - q0); lsum = hi == 0 ? 1.f : 0.f; }
    const bool dovote = (MODE != 0) || (sl2 * (float)(q0 + ROWS) >= 150.0f);
    const bool fixed = REV && !__any(qkb >= 66.0f);
    if (MODE == 0 && fixed) mrun = sl2 * (float)(wq0 + r32 - q0) + qkb - 20.0f;
    f32x16 O[NC];
#pragma unroll
    for (int c = 0; c < NC; ++c)
#pragma unroll
        for (int r = 0; r < 16; ++r) O[c][r] = 0.f;
    LAS float* wsf = (LAS float*)(lds + WS_OFF) + wid * 32;
    const int nt = t_hi - t_lo;
    LAS int* vote = (LAS int*)(lds + VOTE_OFF);
    bool wdone = false;
#define ATT_TILE(i_) (REV ? t_hi - 1 - (i_) : t_lo + (i_))
#define ATT_STEP(it_, KL, VL, LL, KW, VW, LW) do { const int t = ATT_TILE(it_), buf = (it_) & 1, kv0 = t * 64; \
        if ((it_) + 2 < nt) ATT_LOAD(ATT_TILE((it_) + 2), KL, VL, LL); \
        bool need = kv0 <= wq0 + 31; if (MODE == 1) need = need && (kv0 + 63 >= wq0 - 127); \
        if (MODE == 2 && fixed && need && kv0 == (wq0 & ~63)) mrun = ((const LAS float*)(lds + BI_OFF))[buf * 64 + (wq0 & 63) + r32] + qkb - 20.0f;     \
        if (need && !wdone) att_tile<MODE>(lds, buf, kv0, wq0, r32, hi, mapi, qr, O, mrun, lsum, wsf, fixed); \
        if (REV && dovote) { const float b0 = ((const LAS float*)(lds + BI_OFF))[buf * 64]; const int nd = __any(qkb + b0 > mrun - 150.0f) ? 1 : 0; if (lane == 0) vote[buf * 8 + wid] = nd; if (!nd) wdone = true; } \
        if ((it_) + 1 < nt) ATT_WRITE(ATT_TILE((it_) + 1), buf ^ 1, KW, VW, LW); \
        __syncthreads(); \
        if (REV && dovote) { const LAS int* vp = vote + buf * 8; const int any = (vp[0] | vp[1]) | (vp[2] | vp[3]) | (vp[4] | vp[5]) | (vp[6] | vp[7]); if (!any) stop = true; } } while (0)
    ATT_LOAD(ATT_TILE(0), kstA, vstA, lfA); ATT_WRITE(ATT_TILE(0), 0, kstA, vstA, lfA);
    if (nt > 1) ATT_LOAD(ATT_TILE(1), kstB, vstB, lfB);
    __syncthreads();
    bool stop = false;
    for (int it = 0; it < nt; it += 2) {
        ATT_STEP(it, kstA, vstA, lfA, kstB, vstB, lfB);
        if (stop || it + 1 >= nt) break;
        ATT_STEP(it + 1, kstB, vstB, lfB, kstA, vstA, lfA);
        if (stop) break;
    }
#undef ATT_LOAD
#undef ATT_WRITE
#undef ATT_TILE
#undef ATT_STEP
    const float lt = xhalf_sum(lsum);
    if (hi == 0) wsf[r32] = 1.0f / lt;
    asm volatile("s_waitcnt lgkmcnt(0)" ::: "memory");
    float il[16];
#pragma unroll
    for (int i = 0; i < 4; ++i) { const f32x4 av = *(const LAS f32x4*)(wsf + 8 * i + 4 * hi);
#pragma unroll
        for (int k = 0; k < 4; ++k) il[4 * i + k] = av[k]; }
    asm volatile("s_waitcnt lgkmcnt(0)" ::: "memory");
    if (MODE != 0) {
#pragma unroll
        for (int r = 0; r < 16; ++r) { bf16* yp = Y + (tok0 + wq0 + crow(r, hi)) * 1536 + ycol + r32;
#pragma unroll
            for (int c = 0; c < NC; ++c) yp[32 * c] = (bf16)(pk2(O[c][r] * il[r], 0.f) & 0xffffu); }
    } else {
        LAS float* xc = (LAS float*)(lds + XC_OFF) + (wid & 3) * 64 + lane;
        if (mapi == 1) {
#pragma unroll
            for (int c = 0; c < NC; ++c)
#pragma unroll
                for (int r = 0; r < 16; ++r) xc[(c * 16 + r) * 256] = O[c][r] * il[r];
        }
        __syncthreads();
        if (mapi == 0) {
            float ss[16];
#pragma unroll
            for (int r = 0; r < 16; ++r) { float s = 0.f;
#pragma unroll
                for (int c = 0; c < NC; ++c) { const float y = O[c][r] * il[r] - lam * xc[(c * 16 + r) * 256]; O[c][r] = y; s += y * y; }
                ss[r] = s; }
#pragma unroll
            for (int o = 1; o < 32; o <<= 1)
#pragma unroll
                for (int r = 0; r < 16; ++r) ss[r] += __shfl_xor(ss[r], o);
            float gsub[NC];
#pragma unroll
            for (int c = 0; c < NC; ++c) gsub[c] = subg[32 * c + r32] * subfac;
#pragma unroll
            for (int r = 0; r < 16; ++r) { const float inv = 1.0f / sqrtf(ss[r] * (1.f / 128.f) + 1e-5f); bf16* yp = Y + (tok0 + wq0 + crow(r, hi)) * 1536 + ycol + r32;
#pragma unroll
                for (int c = 0; c < NC; ++c) yp[32 * c] = (bf16)(pk2(O[c][r] * inv * gsub[c], 0.f) & 0xffffu); }
        }
    }
}

__device__ __forceinline__ void attn_phase(LAS unsigned char* lds, const Args& a, int layer, int vcu, int G) {
    int lane0_ = threadIdx.x & 63; asm volatile("" : "+v"(lane0_)); const int lane = lane0_;
    const bf16* QK = (const bf16*)(a.ws + WS_QK); const bf16* VT = (const bf16*)(a.ws + WS_VT); bf16* Y = (bf16*)(a.ws + WS_Y); const float* logf = (const float*)(a.ws + WS_LOGF);
    const float lam_init = 0.8f - 0.6f * expf(-0.3f * (float)layer);
    const float s1 = wave_sum(a.in[4][layer * 64 + lane] * a.in[5][layer * 64 + lane]), s2 = wave_sum(a.in[6][layer * 64 + lane] * a.in[7][layer * 64 + lane]);
    const float lam = __int_as_float(__builtin_amdgcn_readfirstlane(__float_as_int(expf(s1) - expf(s2) + lam_init))), subfac = 1.0f - lam_init;
    const float* subg = a.in[8] + layer * 128; const float* sinks = a.in[9] + layer * 8;
    const float* kabs = (const float*)a.ws;
    unsigned* qctr = (unsigned*)(a.ws + 32768);
    LAS unsigned* qslot = (LAS unsigned*)(lds + LDS_BYTES - 128);
    const int qb0 = (int)(xb_xcc_id() & 7u);
#define ATT_QUEUE(mix_, nunits_, ...) do { for (int qi = 0; qi < 8; ++qi) { const int b = (qb0 + qi) & 7; unsigned* ctr_ = qctr + 64 * ((mix_) * 8 + b); \
        if (threadIdx.x == 0) qslot[0] = atomicAdd(ctr_, 1u); \
        __syncthreads(); \
        unsigned u = (unsigned)__builtin_amdgcn_readfirstlane((int)qslot[0]); \
        while (u < (unsigned)(nunits_)) { \
            unsigned nxt_ = 0u; if (threadIdx.x == 0) nxt_ = atomicAdd(ctr_, 1u);     \
            __VA_ARGS__ \
            __syncthreads(); if (threadIdx.x == 0) qslot[0] = nxt_; __syncthreads(); \
            u = (unsigned)__builtin_amdgcn_readfirstlane((int)qslot[0]); } \
        __syncthreads(); } } while (0)
    ATT_QUEUE(0, 128, { const int s = 31 - (int)(u >> 2), h = 3 - (int)(u & 3u); const float sl2 = exp2f(-2.0f * (float)(h + 1)) * LOG2E;
        int l15_ = threadIdx.x & 15; asm volatile("" : "+v"(l15_)); float kinf = kabs[(b * 16 + l15_) * 11 + 2 + (h >> 1)];
        _Pragma("unroll") for (int o = 1; o < 16; o <<= 1) kinf = fmaxf(kinf, __shfl_xor(kinf, o));
        attn_unit<0>(lds, QK, VT, Y, logf, b, h, s, sl2, 0.f, lam, subfac, subg, kinf); });
    ATT_QUEUE(1, 128, { const int s = 15 - (int)(u >> 3), h = (int)(u & 7u);
        int l15_ = threadIdx.x & 15; asm volatile("" : "+v"(l15_)); float kinf = kabs[(b * 16 + l15_) * 11 + 8 + (h >> 2)];
        _Pragma("unroll") for (int o = 1; o < 16; o <<= 1) kinf = fmaxf(kinf, __shfl_xor(kinf, o));
        attn_unit<2>(lds, QK, VT, Y, logf, b, h, s, 0.f, 0.f, 0.f, 0.f, subg, kinf); });
    ATT_QUEUE(2, 128, { const int qb = (int)(u >> 1), h = 4 * (int)(u & 1u); const float sl2 = exp2f(-(float)(h + 1)) * LOG2E;
        attn_unit<1>(lds, QK, VT, Y, logf, b, h, qb, sl2, 0.f, 0.f, 0.f, sinks, 0.f); });
#undef ATT_QUEUE
}

__global__ void __launch_bounds__(512, 2) fwd_kernel(Args a) {
    extern __shared__ __attribute__((aligned(16))) unsigned char lds_raw[];
    LAS unsigned char* lds = (LAS unsigned char*)lds_raw;
    const int tid = threadIdx.x, wave = __builtin_amdgcn_readfirstlane(tid >> 6);
    const int G = gridDim.x, bx = blockIdx.x, vcu = (G % 8 == 0) ? (bx % 8) * (G / 8) + bx / 8 : bx;
    const int gw = vcu * 8 + wave, ngw = G * 8;
    const int lo = a.ph_lo, hi = a.ph_hi;
    bf16* W1T = (bf16*)(a.ws + WS_W1); bf16* WUPT = (bf16*)(a.ws + WS_WUP); bf16* WOT = (bf16*)(a.ws + WS_WO);
    bf16* XB = (bf16*)(a.ws + WS_XB); bf16* Yb = (bf16*)(a.ws + WS_Y); bf16* QK = (bf16*)(a.ws + WS_QK); bf16* VT = (bf16*)(a.ws + WS_VT); bf16* GM = (bf16*)(a.ws + WS_GM);
    volatile LAS unsigned* bst = (volatile LAS unsigned*)(lds + LDS_BYTES - 64);
    if (tid < 16) bst[tid] = 0u;
    __syncthreads();
    XcdBarrier bar; bar.bar = (unsigned*)(a.ws + WS_BAR); bar.x = 0; bar.st = bst;
#define IN(k) (lo <= (k) && (k) < hi)
#define SEAM(k) do { if (IN(k) && IN((k) + 1)) { if ((k) == 0) { cg::this_grid().sync(); bar = xcd_barrier_post((unsigned*)(a.ws + WS_BAR), bst); } else xcd_barrier(bar); } } while (0)
    if (IN(0) && bx == 0) { unsigned* bw = (unsigned*)(a.ws + WS_BAR); for (int i = tid; i < XCD_BAR_WORDS; i += 512) bw[i] = 0u; }
    if (EN(0) && IN(0)) {
        LAS float* scr = (LAS float*)(lds + wave * 16384);
        int lane_ = threadIdx.x & 63; asm volatile("" : "+v"(lane_)); const int lane = lane_;
        for (int it = gw; it < DEPTH * 5632; it += ngw) {
            const int l = it / 5632, r = it % 5632;
            if (r < 4352) { const int rb = r >> 4, kb = r & 15; int src; float sc; const bool ok = w1_map(32 * rb, src, sc);
                transpose_item(a.in[2] + (size_t)l * D * DIN, DIN, src, 64 * kb, W1T + (size_t)l * NW1 * D, D, 32 * rb, 0, sc, a.in[1] + l * D, !ok, scr, lane); }
            else if (r < 5120) { const int r2 = r - 4352, br = r2 >> 8, r3 = r2 & 255, kb = r3 >> 5, nb = r3 & 31;
                transpose_item((br == 0 ? a.in[10] : br == 1 ? a.in[11] : a.in[12]) + (size_t)l * 512 * D, D, 32 * nb, 64 * kb, WUPT + (size_t)l * D * 1536, 1536, 32 * nb, br * 512, 1.f, nullptr, false, scr, lane); }
            else { const int r2 = r - 5120, kb = r2 >> 5, nb = r2 & 31;
                transpose_item(a.in[13] + (size_t)l * D * D, D, 32 * nb, 64 * kb, WOT + (size_t)l * D * D, D, 32 * nb, 0, 1.f, nullptr, false, scr, lane); }
        }
        __syncthreads();
        norm_pass(lds, a, a.in[0], 0, gw, ngw);
    }
    SEAM(0);
    for (int l = 0; l < DEPTH; ++l) {
        const int pb = 1 + 6 * l;
        const bf16* W1l = W1T + (size_t)l * NW1 * D;
        if (EN(1) && IN(pb)) {
            { pg8::Gemm g{XB, W1l, M, N1A, D}; pg8::StaticOrder S; S.init(M, N1A, G, bx); pg8::EpiG1a E{QK, (unsigned*)a.ws};
              pg8::gemm_phase<pg8::EpiG1a, pg8::StaticOrder, true, true>(lds, g, S, E); }
            { pg8::Gemm g{W1l + (size_t)N1A * D, XB, N1V, M, D}; pg8::StaticOrder S; S.init(N1V, M, G, G - 1 - bx); pg8::EpiBf16<0> E{VT, M, nullptr, 0, 0, 1.f};
              pg8::gemm_phase<pg8::EpiBf16<0>, pg8::StaticOrder, true, true>(lds, g, S, E); }
        }
        SEAM(pb);
        if (EN(2) && IN(pb + 1)) attn_phase(lds, a, l, vcu, G);
        SEAM(pb + 1);
        if (EN(3) && IN(pb + 2)) { pg8::Gemm g{XB, W1l + (size_t)(N1A + N1V) * D, M, N1B, D}; pg8::StaticOrder S; S.init(M, N1B, G, bx); pg8::EpiG1b E{Yb, GM};
            pg8::gemm_phase<pg8::EpiG1b, pg8::StaticOrder, true, true>(lds, g, S, E); }
        SEAM(pb + 2);
        if (EN(4) && IN(pb + 3)) { pg8::Gemm g{Yb, WUPT + (size_t)l * D * 1536, M, D, 1536}; pg8::StaticOrder S; S.init(M, D, G, bx); pg8::EpiG3a E{GM, XB};
            pg8::gemm_phase<pg8::EpiG3a, pg8::StaticOrder, true, true, true>(lds, g, S, E); }
        SEAM(pb + 3);
        if (EN(5) && IN(pb + 4)) { pg8::Gemm g{XB, WOT + (size_t)l * D * D, M, D, D}; pg8::StaticOrder S; S.init(M, D, G, bx); pg8::EpiG3b E{l == 0 ? a.in[0] : a.out, a.out};
            pg8::gemm_phase<pg8::EpiG3b, pg8::StaticOrder, true, true>(lds, g, S, E); }
        SEAM(pb + 4);
        if (EN(6) && IN(pb + 5)) { if (l + 1 < DEPTH) norm_pass(lds, a, a.out, l + 1, gw, ngw); else final_pass(a, gw, ngw); }
        if (l + 1 < DEPTH) SEAM(pb + 5);
    }
#undef IN
#undef SEAM
}

extern "C" void kernel_launch(void* const* d_in, const int* in_sizes, int n_in, void* d_out, int out_size, void* d_ws, size_t ws_size, hipStream_t stream) {
    static int grid = 0;
    if (grid == 0) {
        if (n_in != 15 || out_size != M * D || ws_size < WS_END) { fprintf(stderr, "kernel_launch: unexpected shapes (n_in %d out %d ws %zu)\n", n_in, out_size, ws_size); grid = -1; return; }
        int dev = 0, cus = 0, per_cu = 0;
        hipGetDevice(&dev); hipDeviceGetAttribute(&cus, hipDeviceAttributeMultiprocessorCount, dev);
        hipFuncSetAttribute((const void*)fwd_kernel, hipFuncAttributeMaxDynamicSharedMemorySize, LDS_BYTES);
        if (hipOccupancyMaxActiveBlocksPerMultiprocessor(&per_cu, (const void*)fwd_kernel, 512, LDS_BYTES) != hipSuccess || per_cu < 1) per_cu = 1;
        (void)hipGetLastError();
        grid = cus * per_cu;
    }
    if (grid < 0) return;
    Args a{};
    for (int i = 0; i < 15; ++i) a.in[i] = (const float*)d_in[i];
    a.out = (float*)d_out; a.ws = (unsigned char*)d_ws;
#if MK_N_LAUNCHES == 1
    a.ph_lo = 0; a.ph_hi = NPHASE;
    void* args[] = {&a};
    hipError_t e = hipLaunchCooperativeKernel((const void*)fwd_kernel, dim3(grid), dim3(512), args, LDS_BYTES, stream);
    if (e != hipSuccess) fprintf(stderr, "cooperative launch failed: %s (grid %d)\n", hipGetErrorString(e), grid);
#else
    for (int p = 0; p < NPHASE; ++p) { a.ph_lo = p; a.ph_hi = p + 1; hipLaunchKernelGGL(fwd_kernel, dim3(grid), dim3(512), LDS_BYTES, stream, a); }
#endif
}
```
